# Optimizing an MI355X kernel written in HIP

```python
import jax, jax.numpy as jnp
from jax import lax
import numpy as np

D_MODEL = 2048
BATCH = 8
SEQ = 2048
DEPTH = 1

M_HEADS = 4
M_HEAD_DIM = 256
M_WIDTH = M_HEADS * M_HEAD_DIM
M_CHUNK = 64
CONV_WIDTH = 4
A_HEADS = 16
A_KV_HEADS = 4
A_GROUP = A_HEADS // A_KV_HEADS
A_HEAD_DIM = 64
A_WIDTH = A_HEADS * A_HEAD_DIM
A_KV_WIDTH = A_KV_HEADS * A_HEAD_DIM
WINDOW = 128
ROPE_THETA = 10000.0
N_BRANCHES = 2
D_IN = 4 * M_WIDTH + 2 * M_HEADS + A_WIDTH + 2 * A_KV_WIDTH + N_BRANCHES * D_MODEL
N_GROUPS = 8
EXPERTS_PER_GROUP = 8
N_EXPERTS = N_GROUPS * EXPERTS_PER_GROUP
TOP_K = 2
D_EXPERT = 768
MOE_BLOCK = 128
EPS = 1e-6

kernel_name = "hybrid_mlstm_swa_hmoe_layer"


def rms_norm(x, g):
    xf = x.astype(jnp.float32)
    y = xf * lax.rsqrt(jnp.mean(xf * xf, axis=-1, keepdims=True) + EPS)
    return (y * g.astype(jnp.float32)).astype(x.dtype)


def rope(x, pos):
    half = x.shape[-1] // 2
    freqs = ROPE_THETA ** (-jnp.arange(half, dtype=jnp.float32) / half)
    ang = pos.astype(jnp.float32)[:, None] * freqs[None, :]
    cos = jnp.cos(ang)[None, :, None, :]
    sin = jnp.sin(ang)[None, :, None, :]
    xf = x.astype(jnp.float32)
    x1, x2 = xf[..., :half], xf[..., half:]
    return jnp.concatenate([x1 * cos - x2 * sin, x2 * cos + x1 * sin], axis=-1).astype(x.dtype)


def causal_dwconv(x, w):
    K = w.shape[0]
    S = x.shape[1]
    xp = jnp.pad(x, ((0, 0), (K - 1, 0), (0, 0)))
    y = xp[:, 0:S, :] * w[0]
    for j in range(1, K):
        y = y + xp[:, j:j + S, :] * w[j]
    return y


def mlstm_chunkwise(q, k, v, li, lf):
    B, H, S, dk = q.shape
    dv = v.shape[-1]
    L = M_CHUNK
    NC = S // L

    def to_chunks(t):
        t = t.reshape(B, H, NC, L, *t.shape[3:])
        return jnp.moveaxis(t, 2, 0)

    causal = jnp.tril(jnp.ones((L, L), dtype=bool))

    def step(carry, xs):
        C, n, m = carry
        qc, kc, vc, lic, lfc = xs
        b = jnp.cumsum(lfc, axis=-1)
        a = b + m[..., None]
        D = jnp.where(causal, b[..., :, None] - b[..., None, :] + lic[..., None, :], -jnp.inf)
        m_t = jnp.maximum(a, jnp.max(D, axis=-1))
        w_inter = jnp.exp(a - m_t)
        P = jnp.einsum('bhtd,bhsd->bhts', qc, kc) * jnp.exp(D - m_t[..., None])
        num = w_inter[..., None] * jnp.einsum('bhtd,bhde->bhte', qc, C) + jnp.einsum('bhts,bhse->bhte', P, vc)
        qn = w_inter * jnp.einsum('bhtd,bhd->bht', qc, n) + jnp.sum(P, axis=-1)
        den = jnp.maximum(jnp.abs(qn), jnp.exp(-m_t))
        h = num / den[..., None]
        bL = b[..., -1]
        g = bL[..., None] - b + lic
        m_new = jnp.maximum(bL + m, jnp.max(g, axis=-1))
        decay = jnp.exp(bL + m - m_new)
        wk = jnp.exp(g - m_new[..., None])
        C_new = decay[..., None, None] * C + jnp.einsum('bhs,bhsd,bhse->bhde', wk, kc, vc)
        n_new = decay[..., None] * n + jnp.einsum('bhs,bhsd->bhd', wk, kc)
        return (C_new, n_new, m_new), h

    init = (jnp.zeros((B, H, dk, dv), jnp.float32),
            jnp.zeros((B, H, dk), jnp.float32),
            jnp.zeros((B, H), jnp.float32))
    xs = (to_chunks(q), to_chunks(k), to_chunks(v), to_chunks(li), to_chunks(lf))
    _, h = lax.scan(step, init, xs)
    return jnp.moveaxis(h, 0, 2).reshape(B, H, S, dv)


def sliding_window_attention(q, k, v, sinks):
    B, S, _, dh = q.shape
    Bk = WINDOW
    NB = S // Bk
    qb = q.reshape(B, NB, Bk, A_KV_HEADS, A_GROUP, dh)

    def band(t):
        tb = t.reshape(B, NB, Bk, A_KV_HEADS, dh)
        prev = jnp.pad(tb, ((0, 0), (1, 0), (0, 0), (0, 0), (0, 0)))[:, :NB]
        return jnp.concatenate([prev, tb], axis=2)

    kb, vb = band(k), band(v)
    s = jnp.einsum('bnqhgd,bnkhd->bnhgqk', qb, kb).astype(jnp.float32) * (dh ** -0.5)
    qpos = jnp.arange(Bk)[:, None] + Bk
    kpos = jnp.arange(2 * Bk)[None, :]
    rel = qpos - kpos
    allowed = (rel >= 0) & (rel < WINDOW)
    key_abs = (jnp.arange(NB) * Bk - Bk)[:, None] + kpos
    mask = allowed[None] & (key_abs >= 0)[:, None, :]
    s = jnp.where(mask[None, :, None, None, :, :], s, -jnp.inf)
    sink = sinks.astype(jnp.float32).reshape(A_KV_HEADS, A_GROUP)[None, None, :, :, None]
    mx = jnp.maximum(jnp.max(s, axis=-1), sink)
    p = jnp.exp(s - mx[..., None])
    den = jnp.sum(p, axis=-1) + jnp.exp(sink - mx)
    p = (p / den[..., None]).astype(v.dtype)
    o = jnp.einsum('bnhgqk,bnkhd->bnqhgd', p, vb)
    return o.reshape(B, S, A_HEADS, dh)


def hierarchical_moe(x, w_group, b_group, w_expert, b_expert, w_gate, w_up, w_down):
    T, D = x.shape
    g_logits = jnp.matmul(x, w_group).astype(jnp.float32) + b_group.astype(jnp.float32)
    g_prob = jax.nn.softmax(g_logits, axis=-1)
    g_p, g_idx = lax.top_k(g_prob, 1)
    e_logits = (jnp.matmul(x, w_expert).astype(jnp.float32) + b_expert.astype(jnp.float32))
    e_logits = e_logits.reshape(T, N_GROUPS, EXPERTS_PER_GROUP)[jnp.arange(T), g_idx[:, 0]]
    e_prob = jax.nn.softmax(e_logits, axis=-1)
    e_p, e_loc = lax.top_k(e_prob, TOP_K)
    e_p = e_p / jnp.sum(e_p, axis=-1, keepdims=True)
    gate = g_p * e_p
    eid = g_idx * EXPERTS_PER_GROUP + e_loc

    M = T * TOP_K
    eid_f = eid.reshape(M).astype(jnp.int32)
    tok_f = jnp.repeat(jnp.arange(T, dtype=jnp.int32), TOP_K)
    w_f = gate.reshape(M)
    order = jnp.argsort(eid_f)
    e_s, tok_s, w_s = eid_f[order], tok_f[order], w_f[order]
    counts = jnp.bincount(eid_f, length=N_EXPERTS).astype(jnp.int32)
    padded = (counts + MOE_BLOCK - 1) // MOE_BLOCK * MOE_BLOCK
    start = jnp.cumsum(counts) - counts
    pend = jnp.cumsum(padded)
    pstart = pend - padded
    dest = pstart[e_s] + jnp.arange(M, dtype=jnp.int32) - start[e_s]
    n_blocks = -(-M // MOE_BLOCK) + N_EXPERTS
    P = n_blocks * MOE_BLOCK
    row_tok = jnp.zeros((P,), jnp.int32).at[dest].set(tok_s)
    row_w = jnp.zeros((P,), jnp.float32).at[dest].set(w_s)
    blk_e = jnp.minimum(jnp.searchsorted(pend, jnp.arange(n_blocks, dtype=jnp.int32) * MOE_BLOCK, side='right'),
                        N_EXPERTS - 1)
    xr = x[row_tok].reshape(n_blocks, MOE_BLOCK, D)

    def expert_block(args):
        xb, e = args
        h = jax.nn.silu(jnp.matmul(xb, w_gate[e])) * jnp.matmul(xb, w_up[e])
        return jnp.matmul(h, w_down[e])

    yr = lax.map(expert_block, (xr, blk_e)).reshape(P, D)
    y = jax.ops.segment_sum(yr.astype(jnp.float32) * row_w[:, None], row_tok, num_segments=T)
    return y.astype(x.dtype)


def setup_inputs(seed: int = 0) -> dict:
    key = jax.random.key(seed)
    ks = jax.random.split(key, 24)
    f32 = jnp.float32
    nrm = lambda k, shape, scale: jax.random.normal(k, shape, f32) * scale
    return {
        "x": nrm(ks[0], (BATCH, SEQ, D_MODEL), 1.0),
        "g_mix": 1.0 + nrm(ks[1], (DEPTH, D_MODEL), 0.02),
        "w_in": nrm(ks[2], (DEPTH, D_MODEL, D_IN), D_MODEL ** -0.5),
        "conv_qk": nrm(ks[3], (DEPTH, CONV_WIDTH, 2 * M_WIDTH), CONV_WIDTH ** -0.5),
        "b_igate": nrm(ks[4], (DEPTH, M_HEADS), 0.1),
        "b_fgate": jnp.linspace(3.0, 6.0, M_HEADS, dtype=f32)[None, :] + nrm(ks[5], (DEPTH, M_HEADS), 0.1),
        "g_mlstm": 1.0 + nrm(ks[6], (DEPTH, M_HEADS, M_HEAD_DIM), 0.02),
        "g_q": 1.0 + nrm(ks[7], (DEPTH, A_HEAD_DIM), 0.02),
        "g_k": 1.0 + nrm(ks[8], (DEPTH, A_HEAD_DIM), 0.02),
        "sinks": nrm(ks[9], (DEPTH, A_HEADS), 0.5),
        "w_proj_m": nrm(ks[10], (DEPTH, M_WIDTH, D_MODEL), M_WIDTH ** -0.5),
        "w_proj_a": nrm(ks[11], (DEPTH, A_WIDTH, D_MODEL), A_WIDTH ** -0.5),
        "w_out": nrm(ks[12], (DEPTH, D_MODEL, D_MODEL), D_MODEL ** -0.5),
        "g_ffn": 1.0 + nrm(ks[13], (DEPTH, D_MODEL), 0.02),
        "w_group": nrm(ks[14], (DEPTH, D_MODEL, N_GROUPS), D_MODEL ** -0.5),
        "b_group": nrm(ks[15], (DEPTH, N_GROUPS), 0.01),
        "w_expert": nrm(ks[16], (DEPTH, D_MODEL, N_EXPERTS), D_MODEL ** -0.5),
        "b_expert": nrm(ks[17], (DEPTH, N_EXPERTS), 0.01),
        "w_gate": nrm(ks[18], (DEPTH, N_EXPERTS, D_MODEL, D_EXPERT), D_MODEL ** -0.5),
        "w_up": nrm(ks[19], (DEPTH, N_EXPERTS, D_MODEL, D_EXPERT), D_MODEL ** -0.5),
        "w_down": nrm(ks[20], (DEPTH, N_EXPERTS, D_EXPERT, D_MODEL), D_EXPERT ** -0.5),
    }


def reference(x, g_mix, w_in, conv_qk, b_igate, b_fgate, g_mlstm, g_q, g_k, sinks,
              w_proj_m, w_proj_a, w_out, g_ffn, w_group, b_group, w_expert, b_expert,
              w_gate, w_up, w_down):
    B, S, D = x.shape
    f32 = jnp.float32
    sizes = (M_WIDTH, M_WIDTH, M_WIDTH, M_WIDTH, M_HEADS, M_HEADS,
             A_WIDTH, A_KV_WIDTH, A_KV_WIDTH, D_MODEL, D_MODEL)
    cuts = [int(c) for c in np.cumsum(sizes)[:-1]]
    pos = jnp.arange(S, dtype=jnp.int32)
    for l in range(DEPTH):
        h = rms_norm(x, g_mix[l])
        z = jnp.matmul(h, w_in[l])
        mq, mk, mv, mo, mi, mf, aq, ak, av, gm, ga = jnp.split(z, cuts, axis=-1)

        qk = jax.nn.silu(causal_dwconv(jnp.concatenate([mq, mk], axis=-1), conv_qk[l]))
        mq, mk = jnp.split(qk, 2, axis=-1)
        heads = lambda t: t.reshape(B, S, M_HEADS, M_HEAD_DIM).transpose(0, 2, 1, 3).astype(f32)
        li = (mi + b_igate[l]).astype(f32).transpose(0, 2, 1)
        lf = jax.nn.log_sigmoid((mf + b_fgate[l]).astype(f32)).transpose(0, 2, 1)
        hm = mlstm_chunkwise(heads(mq), heads(mk) * (M_HEAD_DIM ** -0.5), heads(mv), li, lf)
        hm = rms_norm(hm.transpose(0, 2, 1, 3), g_mlstm[l])
        hm = hm.reshape(B, S, M_WIDTH).astype(x.dtype) * jax.nn.sigmoid(mo)

        aq = rope(rms_norm(aq.reshape(B, S, A_HEADS, A_HEAD_DIM), g_q[l]), pos)
        ak = rope(rms_norm(ak.reshape(B, S, A_KV_HEADS, A_HEAD_DIM), g_k[l]), pos)
        av = av.reshape(B, S, A_KV_HEADS, A_HEAD_DIM)
        ha = sliding_window_attention(aq, ak, av, sinks[l]).reshape(B, S, A_WIDTH)

        mixed = (jax.nn.sigmoid(gm) * jnp.matmul(hm, w_proj_m[l])
                 + jax.nn.sigmoid(ga) * jnp.matmul(ha, w_proj_a[l]))
        x = x + jnp.matmul(mixed, w_out[l])

        hf = rms_norm(x, g_ffn[l]).reshape(B * S, D)
        y = hierarchical_moe(hf, w_group[l], b_group[l], w_expert[l], b_expert[l],
                             w_gate[l], w_up[l], w_down[l])
        x = x + y.reshape(B, S, D)
    return x
```

```cpp
#include <hip/hip_runtime.h>
#include <hip/hip_bf16.h>
#include <stdint.h>
#ifndef DBL_MASK
#define DBL_MASK 0
#endif

constexpr int D_MODEL = 2048, BATCH = 8, SEQ = 2048, T_TOK = BATCH * SEQ;
constexpr int M_HEADS = 4, M_HD = 256, M_WIDTH = 1024, M_CHUNK = 64;
constexpr int A_HEADS = 16, A_KVH = 4, A_HD = 64, A_WIDTH = 1024, A_KVW = 256, WINDOW = 128;
constexpr int D_IN = 9736;
constexpr int N_GROUPS = 8, EPG = 8, N_EXP = 64, D_EXP = 768;
constexpr float EPS = 1e-6f;
constexpr int NZ = 9728, ZQ = 0, ZK = 1024, ZV = 2048, ZO = 3072, ZAQ = 4096, ZAK = 5120, ZAV = 5376, ZGM = 5632, ZGA = 7680;
constexpr int GATE_TILE0 = ZGM / 256;
constexpr int W_MI = 4096;
constexpr int ECAP = 16384;

typedef unsigned short bf16_t;
typedef short bf16x8 __attribute__((ext_vector_type(8)));
typedef float f32x4 __attribute__((ext_vector_type(4)));
typedef unsigned u32x4 __attribute__((ext_vector_type(4)));
typedef unsigned u32x2 __attribute__((ext_vector_type(2)));
#define LAS __attribute__((address_space(3)))

__device__ __forceinline__ float frcp(float x) { return __builtin_amdgcn_rcpf(x); }
__device__ __forceinline__ float sigmoidf_(float x) { return frcp(1.0f + __expf(-x)); }
__device__ __forceinline__ float siluf_(float x) { return x * frcp(1.0f + __expf(-x)); }
__device__ __forceinline__ float wave_sum(float v) { for (int o = 32; o >= 1; o >>= 1) v += __shfl_xor(v, o); return v; }
__device__ __forceinline__ float wave_max(float v) { for (int o = 32; o >= 1; o >>= 1) v = fmaxf(v, __shfl_xor(v, o)); return v; }
__device__ __forceinline__ float bf2f(bf16_t b) { return __uint_as_float(((unsigned)b) << 16); }
typedef float f32x2_t __attribute__((ext_vector_type(2)));
typedef __bf16 bf16x2_t __attribute__((ext_vector_type(2)));
__device__ __forceinline__ unsigned cvt_pk_bf16(float lo, float hi) { unsigned r; asm volatile("v_cvt_pk_bf16_f32 %0, %1, %2" : "=v"(r) : "v"(lo), "v"(hi)); return r; }
__device__ __forceinline__ unsigned pk_bf16_sw(float lo, float hi) { const f32x2_t v = {lo, hi}; const bf16x2_t r = __builtin_convertvector(v, bf16x2_t); unsigned u; __builtin_memcpy(&u, &r, 4); return u; }
__device__ __forceinline__ bf16_t f2bf(float f) { return (bf16_t)(cvt_pk_bf16(f, 0.f) & 0xffffu); }

#define XB_TMO      128
#define XB_XCNT(j)  (256  + 64 * (j))
#define XB_XSUB(j)  (1280 + 64 * (j))
#define XB_XGEN(j)  (2304 + 64 * (j))
#define XB_TOP      3328
#define XB_TOPGEN   3392
#define XCD_BAR_WORDS 3456
#define XB_SPIN_CAP (1u << 18)
__device__ __forceinline__ unsigned xb_ld(unsigned* p)              { return __hip_atomic_load(p, __ATOMIC_RELAXED, __HIP_MEMORY_SCOPE_AGENT); }
__device__ __forceinline__ unsigned xb_add(unsigned* p, unsigned v) { return __hip_atomic_fetch_add(p, v, __ATOMIC_RELAXED, __HIP_MEMORY_SCOPE_AGENT); }
__device__ __forceinline__ unsigned xb_xcc_id() { return (unsigned)__builtin_amdgcn_s_getreg((3 << 11) | 20) & 0xFu; }
#define XB_SPIN(cond, bar) do { unsigned _sp = 0; while (cond) { __builtin_amdgcn_s_sleep(1); \
    if ((++_sp & 255u) == 0u) { if (xb_ld(&(bar)[XB_TMO])) break; if (_sp > XB_SPIN_CAP) { atomicAdd(&(bar)[XB_TMO], 1u); break; } } } } while (0)
struct XcdBarrier { unsigned* bar; unsigned x; volatile LAS unsigned* st; };
__device__ __forceinline__ XcdBarrier xcd_barrier_post(unsigned* bar, volatile LAS unsigned* st) {
    XcdBarrier b; b.bar = bar; b.x = xb_xcc_id(); b.st = st;
    if (threadIdx.x == 0) (void)xb_add(&bar[XB_XCNT(b.x)], 1u);
    return b;
}
__device__ __forceinline__ void xcd_barrier_complete(unsigned* bar, unsigned x, unsigned& nloc, unsigned& nx) {
    const unsigned G = gridDim.x * gridDim.y * gridDim.z;
    unsigned sum, cnt, mine, sp = 0u;
    for (;;) {
        sum = 0u; cnt = 0u; mine = 0u;
#pragma unroll
        for (unsigned j = 0; j < 16; ++j) { const unsigned c = xb_ld(&bar[XB_XCNT(j)]); sum += c; cnt += (c > 0u) ? 1u : 0u; mine = (j == x) ? c : mine; }
        if (sum == G) break;
        __builtin_amdgcn_s_sleep(1);
        if ((++sp & 255u) == 0u) { if (xb_ld(&bar[XB_TMO])) break; if (sp > XB_SPIN_CAP) { atomicAdd(&bar[XB_TMO], 1u); break; } }
    }
    nloc = mine > 0u ? mine : 1u; nx = cnt > 0u ? cnt : 1u;
}
__device__ __forceinline__ void xcd_barrier(const XcdBarrier& b) {
    asm volatile("s_waitcnt vmcnt(0)" ::: "memory");
    __syncthreads();
    if (threadIdx.x == 0) {
        unsigned* bar = b.bar;
        __builtin_amdgcn_s_waitcnt(0);
        unsigned nloc = b.st[0], nx = b.st[1];
        if (nloc == 0u) { xcd_barrier_complete(bar, b.x, nloc, nx); b.st[0] = nloc; b.st[1] = nx; }
        const unsigned old = xb_add(&bar[XB_XSUB(b.x)], 1u);
        const unsigned gen = old / nloc;
        if (old + 1u == (gen + 1u) * nloc) {
            __builtin_amdgcn_fence(__ATOMIC_RELEASE, "agent");
            asm volatile("s_waitcnt vmcnt(0)" ::: "memory");
            const unsigned og = xb_add(&bar[XB_TOP], 1u);
            const unsigned tg = og / nx;
            if (og + 1u == (tg + 1u) * nx) xb_add(&bar[XB_TOPGEN], 1u);
            else XB_SPIN(xb_ld(&bar[XB_TOPGEN]) == tg, bar);
            __builtin_amdgcn_fence(__ATOMIC_ACQUIRE, "agent");
            xb_add(&bar[XB_XGEN(b.x)], 1u);
            asm volatile("s_waitcnt vmcnt(0)" ::: "memory");
        } else {
            XB_SPIN(xb_ld(&bar[XB_XGEN(b.x)]) == gen, bar);
            __builtin_amdgcn_fence(__ATOMIC_ACQUIRE, "agent");
            asm volatile("s_waitcnt vmcnt(0)" ::: "memory");
        }
    }
    __syncthreads();
}

namespace g8 {
constexpr int BM = 256, BK = 64, HALF = 128, HTB = HALF * BK * 2, STAGE_BYTES = 8 * HTB, NXCD = 8, WGM = 8;
__host__ __device__ __forceinline__ int lds_byte(int r, int c) { const int st = (r >> 4) * 2 + (c >> 5), rr = r & 15, cc = c & 31, ob = rr * 64 + cc * 2; return st * 1024 + (ob ^ (((ob >> 9) & 1) << 5)); }
__host__ __device__ __forceinline__ void stage_rc(int b, int& R, int& C) { const int st = b / 1024, sb = b % 1024, swz = sb ^ (((sb >> 9) & 1) << 5); R = (st >> 1) * 16 + swz / 64; C = (st & 1) * 32 + (swz % 64) / 2; }
__host__ __device__ __forceinline__ int perm32(int rho) { const int n = rho >> 4, i = rho & 15; return 8 * (i >> 2) + 4 * n + (i & 3); }
struct Unit { int pm, pn, a0, a1, nv; };
__device__ __forceinline__ void static_tile(int L, int nM, int nN, int& pm, int& pn) {
    const int nwg = nM * nN; int wgid = L; { const int q = nwg / NXCD, r = nwg % NXCD, xcd = wgid % NXCD, off = wgid / NXCD; wgid = (xcd < r ? xcd * (q + 1) : r * (q + 1) + (xcd - r) * q) + off; }
    const int nig = WGM * nN, gid = wgid / nig, fm = gid * WGM, gsz = (nM - fm) < WGM ? (nM - fm) : WGM;
    pm = fm + ((wgid % nig) % gsz); pn = (wgid % nig) / gsz;
}

typedef int i32x8 __attribute__((ext_vector_type(8)));
typedef int i32x4 __attribute__((ext_vector_type(4)));
__device__ __forceinline__ i32x8 cat8(bf16x8 lo, bf16x8 hi) { u32x4 a, b; __builtin_memcpy(&a, &lo, 16); __builtin_memcpy(&b, &hi, 16); i32x8 r = {(int)a.x, (int)a.y, (int)a.z, (int)a.w, (int)b.x, (int)b.y, (int)b.z, (int)b.w}; return r; }
__device__ __forceinline__ i32x4 as_i4(bf16x8 v) { i32x4 r; __builtin_memcpy(&r, &v, 16); return r; }
__device__ __forceinline__ i32x4 as_i4f(f32x4 v) { i32x4 r; __builtin_memcpy(&r, &v, 16); return r; }
__device__ __forceinline__ f32x4 as_f4(i32x4 v) { f32x4 r; __builtin_memcpy(&r, &v, 16); return r; }
template <class P>
__device__ __forceinline__ void gemm_phase(LAS unsigned char* lds, const P& pol) {
    const int tid = threadIdx.x, wid = __builtin_amdgcn_readfirstlane(tid >> 6), lane = tid & 63, wr = wid >> 2, wc = wid & 3, fr = lane & 15, fq = lane >> 4;
    constexpr int ES = P::ES;
    const int K = pol.K, RB = K * ES, nt = RB / 128;
    unsigned voffA[2][2], voffB[2]; int sR[2], sC[2];
#pragma unroll
    for (int i = 0; i < 2; ++i) { int R, C; stage_rc(tid * 16 + i * 8192, R, C); sR[i] = R; sC[i] = C; const int Rb = P::PERM ? ((R & ~31) + perm32(R & 31)) : R;
        voffA[0][i] = voffA[1][i] = (unsigned)(R * RB + C * 2); voffB[i] = (unsigned)(Rb * RB + C * 2); }
    const size_t kstep = (size_t)(BK * 2);
    const size_t hstepB = (size_t)HALF * RB;
    const size_t hstepA = P::GATHER ? (size_t)0 : hstepB;
    const unsigned ldsw = (unsigned)wid * 1024u;
    const int aoff = lds_byte(wr * 64 + fr, fq * 8), boff = lds_byte(wc * 32 + fr, fq * 8);
#define G8_SA(b, h) (((b) * 2 + (h)) * HTB)
#define G8_SB(b, h) ((4 + (b) * 2 + (h)) * HTB)
#define G8_STAGE_B(bufoff, gbase) do { _Pragma("unroll") for (int _i = 0; _i < 2; ++_i) \
        __builtin_amdgcn_global_load_lds((const unsigned*)((const char*)(gbase) + voffB[_i]), (LAS unsigned*)(lds + (bufoff) + ldsw + _i * 8192), 16, 0, 0); } while (0)
#define G8_STAGE_A(bufoff, gbase, h) do { _Pragma("unroll") for (int _i = 0; _i < 2; ++_i) \
        __builtin_amdgcn_global_load_lds((const unsigned*)((const char*)(gbase) + (h) * hstepA + voffA[P::GATHER ? (h) : 0][_i]), (LAS unsigned*)(lds + (bufoff) + ldsw + _i * 8192), 16, 0, 0); } while (0)
#define G8_LDA(dst, b, h) do { if constexpr (ES == 2 || P::I8) { _Pragma("unroll") for (int m = 0; m < 4; ++m) _Pragma("unroll") for (int k = 0; k < 2; ++k) dst[m][k] = *(const LAS bf16x8*)(lds + G8_SA(b, h) + aoff + m * 2048 + k * 1024); } else { \
        _Pragma("unroll") for (int m = 0; m < 4; ++m) { dst##8[m].lo = *(const LAS i32x4*)(lds + G8_SA(b, h) + aoff + m * 2048); dst##8[m].hi = *(const LAS i32x4*)(lds + G8_SA(b, h) + aoff + m * 2048 + 1024); } } } while (0)
#define G8_LDB(dst, b, h) do { if constexpr (ES == 2 || P::I8) { _Pragma("unroll") for (int n = 0; n < 2; ++n) _Pragma("unroll") for (int k = 0; k < 2; ++k) dst[n][k] = *(const LAS bf16x8*)(lds + G8_SB(b, h) + boff + n * 2048 + k * 1024); } else { \
        _Pragma("unroll") for (int n = 0; n < 2; ++n) { dst##8[n].lo = *(const LAS i32x4*)(lds + G8_SB(b, h) + boff + n * 2048); dst##8[n].hi = *(const LAS i32x4*)(lds + G8_SB(b, h) + boff + n * 2048 + 1024); } } } while (0)
#define G8_MMA(ai, bj, At, Bt) do { __builtin_amdgcn_s_setprio(1); if constexpr (ES == 2) { _Pragma("unroll") for (int m = 0; m < 4; ++m) _Pragma("unroll") for (int n = 0; n < 2; ++n) _Pragma("unroll") for (int k = 0; k < 2; ++k) \
        acc[ai][bj][m][n] = __builtin_amdgcn_mfma_f32_16x16x32_bf16(Bt[n][k], At[m][k], acc[ai][bj][m][n], 0, 0, 0); } else if constexpr (P::I8) { \
        _Pragma("unroll") for (int m = 0; m < 4; ++m) _Pragma("unroll") for (int n = 0; n < 2; ++n) _Pragma("unroll") for (int k = 0; k < 2; ++k) \
        acc[ai][bj][m][n] = as_f4(__builtin_amdgcn_mfma_i32_16x16x64_i8(as_i4(Bt[n][k]), as_i4(At[m][k]), as_i4f(acc[ai][bj][m][n]), 0, 0, 0)); } else { \
        _Pragma("unroll") for (int m = 0; m < 4; ++m) _Pragma("unroll") for (int n = 0; n < 2; ++n) acc[ai][bj][m][n] = __builtin_amdgcn_mfma_scale_f32_16x16x128_f8f6f4(Bt##8[n], At##8[m], acc[ai][bj][m][n], 0, 0, 0, 0, 0, 0); } \
        __builtin_amdgcn_s_setprio(0); } while (0)
#define G8_WAIT_V(n) asm volatile("s_waitcnt vmcnt(" #n ")" ::: "memory")
#define G8_WAIT_L(n) asm volatile("s_waitcnt lgkmcnt(" #n ")" ::: "memory")
#define G8_BAR __builtin_amdgcn_s_barrier()
#define G8_SCHED __builtin_amdgcn_sched_barrier(0)
#define G8_GATHER_OFFS(ui_, u_) do { if constexpr (P::GATHER) { _Pragma("unroll") for (int _h = 0; _h < 2; ++_h) _Pragma("unroll") for (int _i = 0; _i < 2; ++_i) \
        voffA[_h][_i] = pol.rowidx((ui_), (u_), _h * HALF + sR[_i]) * (unsigned)RB + (unsigned)sC[_i] * 2u; } } while (0)
    Unit cur, nxt; int ui = 0;
    if (!pol.next(0, cur)) return;
    f32x4 acc[2][2][4][2];
#pragma unroll
    for (int a = 0; a < 2; ++a)
#pragma unroll
        for (int b = 0; b < 2; ++b)
#pragma unroll
            for (int m = 0; m < 4; ++m)
#pragma unroll
                for (int n = 0; n < 2; ++n) acc[a][b][m][n] = (f32x4){0.f, 0.f, 0.f, 0.f};
    bf16x8 At[4][2], B0[2][2], B1[2][2]; i32x8 At8[4], B08[2], B18[2];
    const char* cA = pol.a_base(cur); const char* cB = pol.b_base(cur);
    G8_GATHER_OFFS(0, cur);
    G8_STAGE_B(G8_SB(0, 0), cB); G8_STAGE_B(G8_SB(0, 1), cB + hstepB); G8_STAGE_A(G8_SA(0, 0), cA, 0); G8_STAGE_A(G8_SA(0, 1), cA, 1);
    if (wr == 1) G8_BAR;
    G8_WAIT_V(2); G8_BAR;
    G8_STAGE_B(G8_SB(1, 0), cB + kstep); G8_STAGE_A(G8_SA(1, 0), cA + kstep, 0); G8_STAGE_B(G8_SB(1, 1), cB + hstepB + kstep);
    G8_WAIT_V(6); G8_BAR;
    for (;;) {
        const bool has_next = pol.next(ui + 1, nxt);
        const bool skip_hi = P::TAILS && cur.nv <= 128;
        const char* nA = has_next ? pol.a_base(nxt) : cA; const char* nB = has_next ? pol.b_base(nxt) : cB;
        for (int t = 0; t < nt; t += 2) {
            const bool last = (t == nt - 2);
            const char* a1 = cA + (size_t)(t + 1) * kstep;
            const char* a2 = last ? nA : cA + (size_t)(t + 2) * kstep; const char* b2 = last ? nB : cB + (size_t)(t + 2) * kstep;
            const char* a3 = a2 + kstep; const char* b3 = b2 + kstep;
            G8_LDB(B0, 0, 0); G8_LDB(B1, 0, 1); G8_SCHED; G8_LDA(At, 0, 0); G8_STAGE_A(G8_SA(1, 1), a1, 1);
            if (last && has_next) G8_GATHER_OFFS(ui + 1, nxt);
            G8_WAIT_V(8); G8_WAIT_L(0); G8_BAR; G8_MMA(0, 0, At, B0); G8_MMA(0, 1, At, B1); G8_BAR; G8_SCHED;
            G8_LDA(At, 0, 1); G8_STAGE_B(G8_SB(0, 0), b2); G8_STAGE_B(G8_SB(0, 1), b2 + hstepB); G8_STAGE_A(G8_SA(0, 0), a2, 0);
            G8_WAIT_V(8); G8_WAIT_L(0); G8_BAR; if (!skip_hi) { G8_MMA(1, 0, At, B0); G8_MMA(1, 1, At, B1); } G8_BAR; G8_SCHED;
            G8_LDB(B0, 1, 0); G8_LDB(B1, 1, 1); G8_SCHED; G8_LDA(At, 1, 0); G8_STAGE_A(G8_SA(0, 1), a2, 1);
            G8_WAIT_V(8); G8_WAIT_L(0); G8_BAR; G8_MMA(0, 0, At, B0); G8_MMA(0, 1, At, B1); G8_BAR; G8_SCHED;
            G8_LDA(At, 1, 1); G8_STAGE_B(G8_SB(1, 0), b3); G8_STAGE_B(G8_SB(1, 1), b3 + hstepB); G8_STAGE_A(G8_SA(1, 0), a3, 0);
            G8_WAIT_V(8); G8_WAIT_L(0); G8_BAR; if (!skip_hi) { G8_MMA(1, 0, At, B0); G8_MMA(1, 1, At, B1); } G8_BAR; G8_SCHED;
        }
        if (wr == 0) G8_BAR;
        const bool zero = pol.epi(acc, cur, wr, wc, fr, fq);
        if (!has_next) break;
        if (zero) {
#pragma unroll
        for (int a = 0; a < 2; ++a)
#pragma unroll
            for (int b = 0; b < 2; ++b)
#pragma unroll
                for (int m = 0; m < 4; ++m)
#pragma unroll
                    for (int n = 0; n < 2; ++n) acc[a][b][m][n] = (f32x4){0.f, 0.f, 0.f, 0.f};
        }
        cur = nxt; cA = nA; cB = nB; ++ui;
        if (wr == 1) G8_BAR;
    }
    G8_WAIT_V(0);
    G8_BAR;
#undef G8_SA
#undef G8_SB
#undef G8_STAGE_A
#undef G8_STAGE_B
#undef G8_LDA
#undef G8_LDB
#undef G8_MMA
#undef G8_WAIT_V
#undef G8_WAIT_L
#undef G8_BAR
#undef G8_SCHED
#undef G8_GATHER_OFFS
}

struct PolDenseBf16 {
    static constexpr bool PERM = true, GATHER = false, TAILS = false; static constexpr int ES = 2; static constexpr bool I8 = false;
    const bf16_t* A; const bf16_t* Bt; bf16_t* O; int M, N, K, ldc, G, c, ilo, ihi;
    __device__ __forceinline__ bool next(int i, Unit& u) const { const int nM = M / BM, nN = N / BM; const long L = (long)(i + ilo) * G + c; if (i + ilo >= ihi || L >= (long)nM * nN) return false; static_tile((int)L, nM, nN, u.pm, u.pn); u.a0 = 0; u.a1 = 0; u.nv = 256; return true; }
    __device__ __forceinline__ const char* a_base(const Unit& u) const { return (const char*)A + (size_t)u.pm * BM * K * 2; }
    __device__ __forceinline__ const char* b_base(const Unit& u) const { return (const char*)Bt + (size_t)u.pn * BM * K * 2; }
    __device__ __forceinline__ unsigned rowidx(int, const Unit&, int) const { return 0u; }
    __device__ __forceinline__ bool epi(f32x4 (&acc)[2][2][4][2], const Unit& u, int wr, int wc, int fr, int fq) const {
        const int row0 = u.pm * BM + wr * 64 + fr, col0 = u.pn * BM + wc * 32 + 8 * fq;
#pragma unroll
        for (int ai = 0; ai < 2; ++ai)
#pragma unroll
            for (int m = 0; m < 4; ++m) { bf16_t* rowp = O + (size_t)(row0 + ai * HALF + m * 16) * ldc + col0;
#pragma unroll
                for (int bj = 0; bj < 2; ++bj) { const f32x4 v0 = acc[ai][bj][m][0], v1 = acc[ai][bj][m][1];
                    u32x4 w; w.x = cvt_pk_bf16(v0[0], v0[1]); w.y = cvt_pk_bf16(v0[2], v0[3]); w.z = cvt_pk_bf16(v1[0], v1[1]); w.w = cvt_pk_bf16(v1[2], v1[3]);
                    *(u32x4*)(rowp + bj * HALF) = w; } }
        return true;
    }
};

struct PolDenseI8 {
    static constexpr bool PERM = true, GATHER = false, TAILS = false; static constexpr int ES = 1; static constexpr bool I8 = true;
    const signed char* A; const signed char* Bt; bf16_t* O; const float* sA; const float* sB; int M, N, K, ldc, G, c, ilo, ihi;
    __device__ __forceinline__ bool next(int i, Unit& u) const { const int nM = M / BM, nN = N / BM; const long L = (long)(i + ilo) * G + c; if (i + ilo >= ihi || L >= (long)nM * nN) return false; static_tile((int)L, nM, nN, u.pm, u.pn); u.a0 = 0; u.a1 = 0; u.nv = 256; return true; }
    __device__ __forceinline__ const char* a_base(const Unit& u) const { return (const char*)A + (size_t)u.pm * BM * K; }
    __device__ __forceinline__ const char* b_base(const Unit& u) const { return (const char*)Bt + (size_t)u.pn * BM * K; }
    __device__ __forceinline__ unsigned rowidx(int, const Unit&, int) const { return 0u; }
    __device__ __forceinline__ bool epi(f32x4 (&acc)[2][2][4][2], const Unit& u, int wr, int wc, int fr, int fq) const {
        const int row0 = u.pm * BM + wr * 64 + fr, col0 = u.pn * BM + wc * 32 + 8 * fq;
        f32x4 sb[2][2];
#pragma unroll
        for (int bj = 0; bj < 2; ++bj) { sb[bj][0] = *(const f32x4*)(sB + col0 + bj * HALF); sb[bj][1] = *(const f32x4*)(sB + col0 + bj * HALF + 4); }
#pragma unroll
        for (int ai = 0; ai < 2; ++ai)
#pragma unroll
            for (int m = 0; m < 4; ++m) { const int row = row0 + ai * HALF + m * 16; const float sa = sA[row]; bf16_t* rowp = O + (size_t)row * ldc + col0;
#pragma unroll
                for (int bj = 0; bj < 2; ++bj) { const i32x4 i0 = as_i4f(acc[ai][bj][m][0]), i1 = as_i4f(acc[ai][bj][m][1]);
                    const f32x4 v0 = (f32x4){(float)i0[0], (float)i0[1], (float)i0[2], (float)i0[3]} * sb[bj][0] * sa, v1 = (f32x4){(float)i1[0], (float)i1[1], (float)i1[2], (float)i1[3]} * sb[bj][1] * sa;
                    if (u.pn >= GATE_TILE0) {
                        unsigned q[8];
#pragma unroll
                        for (int e = 0; e < 8; ++e) { const float s = frcp(1.0f + __expf(-(e < 4 ? v0[e & 3] : v1[e & 3]))); const int qi = __float2int_rn(s * 255.0f); q[e] = (unsigned)(qi < 1 ? 1 : qi); }
                        u32x2 w; w.x = q[0] | (q[1] << 8) | (q[2] << 16) | (q[3] << 24); w.y = q[4] | (q[5] << 8) | (q[6] << 16) | (q[7] << 24);
                        *(u32x2*)((unsigned char*)O + (size_t)row * (ldc * 2) + ZGM * 2 + (col0 + bj * HALF - ZGM)) = w;
                    } else {
                    u32x4 w; w.x = cvt_pk_bf16(v0[0], v0[1]); w.y = cvt_pk_bf16(v0[2], v0[3]); w.z = cvt_pk_bf16(v1[0], v1[1]); w.w = cvt_pk_bf16(v1[2], v1[3]);
                    *(u32x4*)(rowp + bj * HALF) = w; } } }
        return true;
    }
};
struct PolProj {
    static constexpr bool PERM = true, GATHER = false, TAILS = false; static constexpr int ES = 2; static constexpr bool I8 = false;
    const bf16_t* hm; const bf16_t* ha; const bf16_t* Wm; const bf16_t* Wa; const bf16_t* z2; bf16_t* mixed; int K, G, c;
    __device__ __forceinline__ bool next(int i, Unit& u) const { const long L = (long)(i >> 1) * G + c; if (L >= 64 * 8) return false; static_tile((int)L, 64, 8, u.pm, u.pn); u.a0 = i & 1; u.a1 = 0; u.nv = 256; return true; }
    __device__ __forceinline__ const char* a_base(const Unit& u) const { return (const char*)(u.a0 ? ha : hm) + (size_t)u.pm * BM * K * 2; }
    __device__ __forceinline__ const char* b_base(const Unit& u) const { return (const char*)(u.a0 ? Wa : Wm) + (size_t)u.pn * BM * K * 2; }
    __device__ __forceinline__ unsigned rowidx(int, const Unit&, int) const { return 0u; }
    __device__ __forceinline__ bool epi(f32x4 (&acc)[2][2][4][2], const Unit& u, int wr, int wc, int fr, int fq) const {
        const int row0 = u.pm * BM + wr * 64 + fr, col0 = u.pn * BM + wc * 32 + 8 * fq;
#pragma unroll
        for (int ai = 0; ai < 2; ++ai)
#pragma unroll
            for (int m = 0; m < 4; ++m) { const size_t row = (size_t)(row0 + ai * HALF + m * 16);
#pragma unroll
                for (int bj = 0; bj < 2; ++bj) { const int col = col0 + bj * HALF;
                    const unsigned char* grow = (const unsigned char*)z2 + row * (NZ * 2) + ZGM * 2;
                    const u32x2 ga = *(const u32x2*)(grow + 2048 + col);
                    float sa[8];
#pragma unroll
                    for (int e = 0; e < 8; ++e) sa[e] = (float)(((e < 4 ? ga.x : ga.y) >> (8 * (e & 3))) & 0xffu);
                    if (u.a0 == 0) {
                        const u32x2 gm = *(const u32x2*)(grow + col);
#pragma unroll
                        for (int e = 0; e < 8; ++e) { const float sm = (float)(((e < 4 ? gm.x : gm.y) >> (8 * (e & 3))) & 0xffu); acc[ai][bj][m][e >> 2][e & 3] *= sm * frcp(sa[e]); }
                    } else {
                        float o[8];
#pragma unroll
                        for (int e = 0; e < 8; ++e) o[e] = acc[ai][bj][m][e >> 2][e & 3] * (sa[e] * (1.0f / 255.0f));
                        u32x4 w; w.x = cvt_pk_bf16(o[0], o[1]); w.y = cvt_pk_bf16(o[2], o[3]); w.z = cvt_pk_bf16(o[4], o[5]); w.w = cvt_pk_bf16(o[6], o[7]);
                        *(u32x4*)(mixed + row * 2048 + col) = w; } } }
        return u.a0 != 0;
    }
};
struct PolDenseBf16Res {
    static constexpr bool PERM = true, GATHER = false, TAILS = false; static constexpr int ES = 2; static constexpr bool I8 = false;
    const bf16_t* A; const bf16_t* Bt; const bf16_t* R; bf16_t* C; int M, N, K, ldc, G, c;
    __device__ __forceinline__ bool next(int i, Unit& u) const { const int nM = M / BM, nN = N / BM; const long L = (long)i * G + c; if (L >= (long)nM * nN) return false; static_tile((int)L, nM, nN, u.pm, u.pn); u.a0 = 0; u.a1 = 0; u.nv = 256; return true; }
    __device__ __forceinline__ const char* a_base(const Unit& u) const { return (const char*)A + (size_t)u.pm * BM * K * 2; }
    __device__ __forceinline__ const char* b_base(const Unit& u) const { return (const char*)Bt + (size_t)u.pn * BM * K * 2; }
    __device__ __forceinline__ unsigned rowidx(int, const Unit&, int) const { return 0u; }
    __device__ __forceinline__ bool epi(f32x4 (&acc)[2][2][4][2], const Unit& u, int wr, int wc, int fr, int fq) const {
        const int row0 = u.pm * BM + wr * 64 + fr, col0 = u.pn * BM + wc * 32 + 8 * fq;
#pragma unroll
        for (int ai = 0; ai < 2; ++ai)
#pragma unroll
            for (int m = 0; m < 4; ++m) { const size_t off = (size_t)(row0 + ai * HALF + m * 16) * ldc + col0;
#pragma unroll
                for (int bj = 0; bj < 2; ++bj) { const u32x4 rw = *(const u32x4*)(R + off + bj * HALF);
                    const f32x4 r0 = (f32x4){__uint_as_float(rw.x << 16), __uint_as_float(rw.x & 0xffff0000u), __uint_as_float(rw.y << 16), __uint_as_float(rw.y & 0xffff0000u)}, r1 = (f32x4){__uint_as_float(rw.z << 16), __uint_as_float(rw.z & 0xffff0000u), __uint_as_float(rw.w << 16), __uint_as_float(rw.w & 0xffff0000u)};
                    const f32x4 v0 = acc[ai][bj][m][0] + r0, v1 = acc[ai][bj][m][1] + r1;
                    u32x4 w; w.x = cvt_pk_bf16(v0[0], v0[1]); w.y = cvt_pk_bf16(v0[2], v0[3]); w.z = cvt_pk_bf16(v1[0], v1[1]); w.w = cvt_pk_bf16(v1[2], v1[3]);
                    *(u32x4*)(C + off + bj * HALF) = w; } }
        return true;
    }
};
struct MoePlan { const LAS int* cnt; const LAS int* tstart; const LAS int* rt2e; int NT; };
struct PolMoe1 {
    static constexpr bool PERM = true, GATHER = true, TAILS = true; static constexpr int ES = 1; static constexpr bool I8 = false;
    const unsigned char* hf; const unsigned char* Wgu; unsigned char* Hmid; const LAS int* tokT; MoePlan pl; int K, G, c;
    __device__ __forceinline__ bool next(int i, Unit& u) const { const int L = i * G + c; if (L >= pl.NT * 6) return false; const int rt = L / 6; u.pm = rt; u.pn = L - rt * 6; const int e = pl.rt2e[rt]; u.a0 = e; u.a1 = (rt - pl.tstart[e]) * 256; u.nv = pl.cnt[e] - u.a1; return true; }
    __device__ __forceinline__ const char* a_base(const Unit&) const { return (const char*)hf; }
    __device__ __forceinline__ const char* b_base(const Unit& u) const { return (const char*)Wgu + ((size_t)u.a0 * 1536 + (size_t)u.pn * 256) * 2048; }
    __device__ __forceinline__ unsigned rowidx(int ui, const Unit&, int r) const { return (unsigned)tokT[ui * 256 + r]; }
    __device__ __forceinline__ bool epi(f32x4 (&acc)[2][2][4][2], const Unit& u, int wr, int wc, int fr, int fq) const {
        const int row0 = u.pm * BM + wr * 64 + fr, col0 = u.pn * 128 + wc * 32 + 8 * fq;
#pragma unroll
        for (int ai = 0; ai < 2; ++ai)
#pragma unroll
            for (int m = 0; m < 4; ++m) { float o[8];
#pragma unroll
                for (int e = 0; e < 8; ++e) { const float gq = acc[ai][0][m][e >> 2][e & 3] * (1.0f / 64.0f), uq = acc[ai][1][m][e >> 2][e & 3] * (1.0f / 64.0f); o[e] = gq * frcp(1.0f + __expf(-gq)) * uq; }
                int w0 = 0, w1 = 0; w0 = __builtin_amdgcn_cvt_pk_fp8_f32(o[0], o[1], w0, false); w0 = __builtin_amdgcn_cvt_pk_fp8_f32(o[2], o[3], w0, true); w1 = __builtin_amdgcn_cvt_pk_fp8_f32(o[4], o[5], w1, false); w1 = __builtin_amdgcn_cvt_pk_fp8_f32(o[6], o[7], w1, true);
                u32x2 w; w.x = (unsigned)w0; w.y = (unsigned)w1; *(u32x2*)(Hmid + (size_t)(row0 + ai * HALF + m * 16) * 768 + col0) = w; }
        return true;
    }
};
struct PolMoe2 {
    static constexpr bool PERM = true, GATHER = false, TAILS = true; static constexpr int ES = 1; static constexpr bool I8 = false;
    const unsigned char* Hmid; const unsigned char* Wdn; unsigned char* yr; MoePlan pl; int K, G, c;
    __device__ __forceinline__ bool next(int i, Unit& u) const { const int L = i * G + c; if (L >= pl.NT * 8) return false; const int rt = L >> 3; u.pm = rt; u.pn = L & 7; const int e = pl.rt2e[rt]; u.a0 = e; u.a1 = 0; u.nv = pl.cnt[e] - (rt - pl.tstart[e]) * 256; return true; }
    __device__ __forceinline__ const char* a_base(const Unit& u) const { return (const char*)Hmid + (size_t)u.pm * BM * 768; }
    __device__ __forceinline__ const char* b_base(const Unit& u) const { return (const char*)Wdn + ((size_t)u.a0 * 2048 + (size_t)u.pn * 256) * 768; }
    __device__ __forceinline__ unsigned rowidx(int, const Unit&, int) const { return 0u; }
    __device__ __forceinline__ bool epi(f32x4 (&acc)[2][2][4][2], const Unit& u, int wr, int wc, int fr, int fq) const {
        const int row0 = u.pm * BM + wr * 64 + fr, col0 = u.pn * BM + wc * 32 + 8 * fq;
#pragma unroll
        for (int ai = 0; ai < 2; ++ai)
#pragma unroll
            for (int m = 0; m < 4; ++m) { unsigned char* rowp = yr + (size_t)(row0 + ai * HALF + m * 16) * 2048 + col0;
#pragma unroll
                for (int bj = 0; bj < 2; ++bj) { const f32x4 v0 = acc[ai][bj][m][0] * (1.0f / 32.0f), v1 = acc[ai][bj][m][1] * (1.0f / 32.0f);
                    int w0 = 0, w1 = 0; w0 = __builtin_amdgcn_cvt_pk_fp8_f32(v0[0], v0[1], w0, false); w0 = __builtin_amdgcn_cvt_pk_fp8_f32(v0[2], v0[3], w0, true); w1 = __builtin_amdgcn_cvt_pk_fp8_f32(v1[0], v1[1], w1, false); w1 = __builtin_amdgcn_cvt_pk_fp8_f32(v1[2], v1[3], w1, true);
                    u32x2 w; w.x = (unsigned)w0; w.y = (unsigned)w1; *(u32x2*)(rowp + bj * HALF) = w; } }
        return true;
    }
};
}

#define LDS_BARRIER() do { asm volatile("s_waitcnt lgkmcnt(0)" ::: "memory"); __builtin_amdgcn_s_barrier(); asm volatile("" ::: "memory"); } while (0)
constexpr int NTHR = 512, LDS_BYTES = 160 * 1024, LDS_MISC = 144 * 1024;

__device__ __forceinline__ void cvt_tile(const float* __restrict__ src, int ld, int k0, int ncol0, bf16_t* __restrict__ dst_row0, int K, int lane) {
    const int c8 = lane & 7, kg = lane >> 3;
    f32x4 v[2][8];
#pragma unroll
    for (int ps = 0; ps < 2; ++ps)
#pragma unroll
        for (int i = 0; i < 8; ++i) v[ps][i] = __builtin_nontemporal_load((const f32x4*)(src + (size_t)(k0 + kg * 8 + i) * ld + ncol0 + 32 * ps + 4 * c8));
#pragma unroll
    for (int ps = 0; ps < 2; ++ps)
#pragma unroll
        for (int j = 0; j < 4; ++j) { u32x4 w; w.x = cvt_pk_bf16(v[ps][0][j], v[ps][1][j]); w.y = cvt_pk_bf16(v[ps][2][j], v[ps][3][j]); w.z = cvt_pk_bf16(v[ps][4][j], v[ps][5][j]); w.w = cvt_pk_bf16(v[ps][6][j], v[ps][7][j]);
            *(u32x4*)(dst_row0 + (size_t)(32 * ps + 4 * c8 + j) * K + k0 + kg * 8) = w; }
}

struct Ptrs {
    const float* in[21]; float* out; unsigned char* ws; int cvt_all, mix_mask, dbl, pad;
};
constexpr size_t al256(size_t x) { return (x + 255) & ~(size_t)255; }
constexpr size_t WS_CTL = 0;
constexpr size_t CTL_BYTES = 65536;
constexpr size_t WS_LI = WS_CTL + CTL_BYTES;
constexpr size_t WS_LF = WS_LI + 32 * 2048 * 4;
constexpr size_t WS_BC = WS_LF + 32 * 2048 * 4;
constexpr size_t WS_UU = WS_BC + 32 * 2048 * 4;
constexpr size_t WS_PM = WS_UU + 32 * 2048 * 4;
constexpr size_t WS_WRH = WS_PM + 32 * 2048 * 4;
constexpr size_t WS_WRL = WS_WRH + 80 * 2048 * 2;
constexpr size_t WS_SA = WS_WRL + 80 * 2048 * 2;
constexpr size_t WS_SB = WS_SA + (size_t)T_TOK * 4;
constexpr size_t WS_WTIN = WS_SB + 10240 * 4;
constexpr size_t WS_WTPM = WS_WTIN + (size_t)NZ * 2048 * 2;
constexpr size_t WS_WTPA = WS_WTPM + (size_t)2048 * 1024 * 2;
constexpr size_t WS_WTOUT = WS_WTPA + (size_t)2048 * 1024 * 2;
constexpr size_t WS_WTGU = WS_WTOUT + (size_t)2048 * 2048 * 2;
constexpr size_t WS_WTDN = WS_WTGU + (size_t)64 * 1536 * 2048 * 2;
constexpr size_t WS_H1 = WS_WTDN + (size_t)64 * 2048 * 768 * 2;
constexpr size_t WS_X1B = WS_H1 + (size_t)T_TOK * 2048 * 2;
constexpr size_t WS_XB = WS_WTGU + (size_t)64 * 1536 * 2048;
constexpr size_t WS_HM = WS_H1 + (size_t)T_TOK * 2048 * 2;
constexpr size_t WS_HA = WS_HM + (size_t)T_TOK * 1024 * 2;
constexpr size_t WS_MIXED = WS_HA + (size_t)T_TOK * 1024 * 2;
constexpr size_t WS_TOKOF = WS_MIXED + (size_t)T_TOK * 2048 * 2;
constexpr size_t WS_ASG = WS_TOKOF + (size_t)N_EXP * ECAP * 4;
constexpr size_t WS_GW = WS_ASG + (size_t)T_TOK * 2 * 4;
constexpr size_t WS_QC = WS_GW + (size_t)T_TOK * 2 * 4;
constexpr size_t WS_KC = WS_QC + (size_t)T_TOK * 1024 * 2;
constexpr size_t WS_KT = WS_KC + (size_t)T_TOK * 1024 * 2;
constexpr size_t WS_VT = WS_KT + (size_t)T_TOK * 1024 * 2;
constexpr size_t WS_AQR = WS_VT + (size_t)T_TOK * 1024 * 2;
constexpr size_t WS_AKR = WS_AQR + (size_t)T_TOK * 1024 * 2;
constexpr size_t WS_AVT = WS_AKR + (size_t)T_TOK * 256 * 2;
constexpr size_t WS_HRAW = WS_AVT + (size_t)T_TOK * 256 * 2;
constexpr size_t WS_Z2 = WS_HRAW + (size_t)T_TOK * 1024 * 4;
constexpr size_t WS_HMID = WS_Z2;
constexpr size_t WS_YR = WS_HMID + (size_t)49152 * 768 * 2;
constexpr size_t WS_FAST_END = WS_Z2 + (size_t)T_TOK * NZ * 2;
static_assert(WS_YR + (size_t)49152 * 2048 * 2 <= WS_FAST_END, "Hmid + yr must fit in the z2 region");
constexpr int CW_BAR = 0;
constexpr int CW_CNT = 12288;
constexpr int MAXRT = 192;

struct CvtJob { const float* src; unsigned char* dst; int ld, K; float scale; };
__device__ __forceinline__ CvtJob cvt_expert_job(const Ptrs& p, int job) {
    CvtJob j;
    if (job < 64 * 24 * 32) {
        const int kl = job & 7, rest = job >> 3; const int nb = rest % 24, kb = ((rest / 24) & 3) * 8 + kl, e = rest / (24 * 4); const int pn = nb >> 2, q = nb & 3;
        j.src = p.in[(q < 2) ? 18 : 19] + (size_t)e * 2048 * 768 + (size_t)(kb * 64) * 768 + pn * 128 + (q & 1) * 64; j.ld = 768;
        j.dst = (unsigned char*)(p.ws + WS_WTGU) + ((size_t)e * 1536 + (size_t)nb * 64) * 2048 + kb * 64; j.K = 2048; j.scale = 64.0f;
    } else {
        const int jb = job - 64 * 24 * 32; const int kl = jb & 3, rest = jb >> 2; const int nb = rest % 32, kb = ((rest / 32) % 3) * 4 + kl, e = rest / (32 * 3);
        j.src = p.in[20] + (size_t)e * 768 * 2048 + (size_t)(kb * 64) * 2048 + nb * 64; j.ld = 2048;
        j.dst = (unsigned char*)(p.ws + WS_WTDN) + ((size_t)e * 2048 + (size_t)nb * 64) * 768 + kb * 64; j.K = 768; j.scale = 32.0f;
    }
    return j;
}
__device__ __forceinline__ void cvt_load(const CvtJob& j, int lane, f32x4 (&v)[2][8]) {
    const int c8 = lane & 7, kg = lane >> 3;
#pragma unroll
    for (int ps = 0; ps < 2; ++ps)
#pragma unroll
        for (int i = 0; i < 8; ++i) v[ps][i] = __builtin_nontemporal_load((const f32x4*)(j.src + (size_t)(kg * 8 + i) * j.ld + 32 * ps + 4 * c8));
}
__device__ __forceinline__ void cvt_store(const CvtJob& j, int lane, const f32x4 (&v)[2][8]) {
    const int c8 = lane & 7, kg = lane >> 3; const float s = j.scale;
#pragma unroll
    for (int ps = 0; ps < 2; ++ps)
#pragma unroll
        for (int jj = 0; jj < 4; ++jj) { int w0 = 0, w1 = 0;
            w0 = __builtin_amdgcn_cvt_pk_fp8_f32(v[ps][0][jj] * s, v[ps][1][jj] * s, w0, false); w0 = __builtin_amdgcn_cvt_pk_fp8_f32(v[ps][2][jj] * s, v[ps][3][jj] * s, w0, true);
            w1 = __builtin_amdgcn_cvt_pk_fp8_f32(v[ps][4][jj] * s, v[ps][5][jj] * s, w1, false); w1 = __builtin_amdgcn_cvt_pk_fp8_f32(v[ps][6][jj] * s, v[ps][7][jj] * s, w1, true);
            u32x2 w; w.x = (unsigned)w0; w.y = (unsigned)w1; *(u32x2*)(j.dst + (size_t)(32 * ps + 4 * c8 + jj) * j.K + kg * 8) = w; }
}
__device__ __forceinline__ void cvt_experts(const Ptrs& p, LAS unsigned char* lds) {
    const int tid = threadIdx.x, lane = tid & 63, wid = __builtin_amdgcn_readfirstlane(tid >> 6), c = blockIdx.x, c8 = lane & 7, kg = lane >> 3;
    constexpr int NJ = 64 * 24 * 32 + 64 * 32 * 12;
    const int nvw = gridDim.x * 8;
    LAS unsigned char* wl = lds + wid * 16384;
    __syncthreads();
#define CVT_ISSUE(J, ps, h) do { _Pragma("unroll") for (int _i = 0; _i < 8; ++_i) \
        __builtin_amdgcn_global_load_lds((const unsigned*)((J).src + (size_t)(kg * 8 + _i) * (J).ld + 32 * (ps) + 4 * c8), (LAS unsigned*)(wl + (h) * 8192 + _i * 1024), 16, 0, 0); } while (0)
#define CVT_FINISH(J, ps, h) do { f32x4 _v[8]; _Pragma("unroll") for (int _i = 0; _i < 8; ++_i) _v[_i] = *(const LAS f32x4*)(wl + (h) * 8192 + _i * 1024 + lane * 16); \
        const float _s = (J).scale; _Pragma("unroll") for (int _jj = 0; _jj < 4; ++_jj) { int _w0 = 0, _w1 = 0; \
            _w0 = __builtin_amdgcn_cvt_pk_fp8_f32(_v[0][_jj] * _s, _v[1][_jj] * _s, _w0, false); _w0 = __builtin_amdgcn_cvt_pk_fp8_f32(_v[2][_jj] * _s, _v[3][_jj] * _s, _w0, true); \
            _w1 = __builtin_amdgcn_cvt_pk_fp8_f32(_v[4][_jj] * _s, _v[5][_jj] * _s, _w1, false); _w1 = __builtin_amdgcn_cvt_pk_fp8_f32(_v[6][_jj] * _s, _v[7][_jj] * _s, _w1, true); \
            u32x2 _w; _w.x = (unsigned)_w0; _w.y = (unsigned)_w1; *(u32x2*)((J).dst + (size_t)(32 * (ps) + 4 * c8 + _jj) * (J).K + kg * 8) = _w; } \
        asm volatile("s_waitcnt lgkmcnt(0)" ::: "memory"); } while (0)
    int job = c * 8 + wid;
    if (job < NJ) {
        CvtJob ja = cvt_expert_job(p, job);
        CVT_ISSUE(ja, 0, 0); CVT_ISSUE(ja, 1, 1);
        for (;;) {
            const int nj = job + nvw; const bool hn = nj < NJ; CvtJob jb = ja; if (hn) jb = cvt_expert_job(p, nj);
            asm volatile("s_waitcnt vmcnt(8)" ::: "memory");
            CVT_FINISH(ja, 0, 0);
            if (hn) { CVT_ISSUE(jb, 0, 0); asm volatile("s_waitcnt vmcnt(8)" ::: "memory"); } else asm volatile("s_waitcnt vmcnt(0)" ::: "memory");
            CVT_FINISH(ja, 1, 1);
            if (!hn) break;
            CVT_ISSUE(jb, 1, 1);
            ja = jb; job = nj;
        }
    }
    asm volatile("s_waitcnt vmcnt(0)" ::: "memory");
    for (int tj = c * 8 + wid; tj < 2048; tj += nvw) {
        if (tj < 1024) { const int which = tj >> 9, j2 = tj & 511, kl = j2 & 7, rest = j2 >> 3, nb = rest % 32, kb = (rest / 32) * 8 + kl;
            cvt_tile(p.in[10 + which], 2048, kb * 64, nb * 64, (bf16_t*)(p.ws + (which ? WS_WTPA : WS_WTPM)) + (size_t)nb * 64 * 1024, 1024, lane); }
        else { const int job = tj - 1024, kl = job & 7, rest = job >> 3; const int nb = rest % 32, kb = (rest / 32) * 8 + kl;
            cvt_tile(p.in[12], 2048, kb * 64, nb * 64, (bf16_t*)(p.ws + WS_WTOUT) + (size_t)nb * 64 * 2048, 2048, lane); } }
    __syncthreads();
#undef CVT_ISSUE
#undef CVT_FINISH
}

__device__ __forceinline__ void phase0(const Ptrs& p, LAS unsigned char* lds) {
    const int tid = threadIdx.x, lane = tid & 63, wid = tid >> 6, gw = blockIdx.x * 8 + wid, nw = gridDim.x * 8;
    { const float* w_in = p.in[2]; signed char* dst = (signed char*)(p.ws + WS_WTIN); float* sB = (float*)(p.ws + WS_SB); LAS float* cm = (LAS float*)lds;
      int tz = tid; asm volatile("" : "+v"(tz)); const int lane = tz & 63, wid = tz >> 6;
      const int c8 = lane & 7, kg = lane >> 3;
      for (int jn = blockIdx.x; jn < NZ / 64; jn += gridDim.x) { const int n0 = jn * 64; const float* srcp = w_in + n0 + (n0 >= 4096 ? 8 : 0) + (size_t)(wid * 256 + kg * 8) * D_IN + 4 * c8;
          float mx[2][4];
#pragma unroll
          for (int ps = 0; ps < 2; ++ps) {
#pragma unroll
              for (int jj = 0; jj < 4; ++jj) mx[ps][jj] = 0.f;
              for (int kb = 0; kb < 4; ++kb) { f32x4 v[8];
#pragma unroll
                  for (int i = 0; i < 8; ++i) v[i] = *(const f32x4*)(srcp + (size_t)(kb * 64 + i) * D_IN + 32 * ps);
#pragma unroll
                  for (int i = 0; i < 8; ++i)
#pragma unroll
                      for (int jj = 0; jj < 4; ++jj) mx[ps][jj] = fmaxf(mx[ps][jj], fabsf(v[i][jj]));
                  asm volatile("" ::: "memory"); }
#pragma unroll
              for (int jj = 0; jj < 4; ++jj) { float m = mx[ps][jj]; m = fmaxf(m, __shfl_xor(m, 8)); m = fmaxf(m, __shfl_xor(m, 16)); m = fmaxf(m, __shfl_xor(m, 32)); if (kg == 0) cm[wid * 64 + 32 * ps + 4 * c8 + jj] = m; } }
          __syncthreads();
#pragma unroll
          for (int ps = 0; ps < 2; ++ps) { float inv[4];
#pragma unroll
              for (int jj = 0; jj < 4; ++jj) { float m = 0.f;
#pragma unroll
                  for (int w8 = 0; w8 < 8; ++w8) m = fmaxf(m, cm[w8 * 64 + 32 * ps + 4 * c8 + jj]);
                  inv[jj] = m > 0.f ? 127.0f / m : 0.f; if (wid == 0 && kg == 0) sB[n0 + 32 * ps + 4 * c8 + jj] = m > 0.f ? m * (1.0f / 127.0f) : 1.0f; }
              for (int kb = 0; kb < 4; ++kb) { f32x4 v[8];
#pragma unroll
                  for (int i = 0; i < 8; ++i) v[i] = *(const f32x4*)(srcp + (size_t)(kb * 64 + i) * D_IN + 32 * ps);
#pragma unroll
                  for (int jj = 0; jj < 4; ++jj) { int q[8];
#pragma unroll
                      for (int i = 0; i < 8; ++i) q[i] = __float2int_rn(v[i][jj] * inv[jj]) & 0xff;
                      u32x2 w; w.x = (unsigned)(q[0] | (q[1] << 8) | (q[2] << 16) | (q[3] << 24)); w.y = (unsigned)(q[4] | (q[5] << 8) | (q[6] << 16) | (q[7] << 24));
                      *(u32x2*)(dst + (size_t)(n0 + 32 * ps + 4 * c8 + jj) * 2048 + wid * 256 + kb * 64 + kg * 8) = w; }
                  asm volatile("" ::: "memory"); } }
          __syncthreads(); } }
    { bf16_t* wrh = (bf16_t*)(p.ws + WS_WRH); bf16_t* wrl = (bf16_t*)(p.ws + WS_WRL); const float* gf = p.in[13]; const float* wgp = p.in[14]; const float* wep = p.in[16];
      for (int idx = blockIdx.x * NTHR + tid; idx < 80 * 256; idx += gridDim.x * NTHR) { const int j = idx >> 8, k8 = (idx & 255) * 8; float hi[8], lo[8];
#pragma unroll
          for (int i = 0; i < 8; ++i) { const int k = k8 + i; const float w = (j < 8) ? wgp[(size_t)k * 8 + j] : (j < 72 ? wep[(size_t)k * 64 + (j - 8)] : 0.f); const float v = w * gf[k];
              const float h = bf2f(f2bf(v)); hi[i] = h; lo[i] = v - h; }
          u32x4 a, bq; a.x = cvt_pk_bf16(hi[0], hi[1]); a.y = cvt_pk_bf16(hi[2], hi[3]); a.z = cvt_pk_bf16(hi[4], hi[5]); a.w = cvt_pk_bf16(hi[6], hi[7]);
          bq.x = cvt_pk_bf16(lo[0], lo[1]); bq.y = cvt_pk_bf16(lo[2], lo[3]); bq.z = cvt_pk_bf16(lo[4], lo[5]); bq.w = cvt_pk_bf16(lo[6], lo[7]);
          *(u32x4*)(wrh + (size_t)j * 2048 + k8) = a; *(u32x4*)(wrl + (size_t)j * 2048 + k8) = bq; } }
    LAS float* w8t = (LAS float*)lds;
    { const float* w_in = p.in[2]; for (int i = tid; i < 2048 * 8; i += NTHR) { const int k = i >> 3, j = i & 7; w8t[j * 2048 + k] = w_in[(size_t)k * D_IN + W_MI + j]; } }
    __syncthreads();
    int tz2 = tid; asm volatile("" : "+v"(tz2)); const int lane2 = tz2 & 63;
    const float* x = p.in[0]; const float* g = p.in[1]; bf16_t* xbp = (bf16_t*)(p.ws + WS_XB); signed char* h8 = (signed char*)(p.ws + WS_H1); float* sA = (float*)(p.ws + WS_SA); float* li = (float*)(p.ws + WS_LI); float* lf = (float*)(p.ws + WS_LF);
    f32x4 gv[8];
#pragma unroll
    for (int i = 0; i < 8; ++i) gv[i] = *(const f32x4*)(g + i * 256 + lane2 * 4);
    const int rlo = (gridDim.x == 256) ? ((int)blockIdx.x < 152 ? 32 * (int)blockIdx.x : 4864 + 111 * ((int)blockIdx.x - 152)) : 0;
    const int rhi = (gridDim.x == 256) ? ((int)blockIdx.x < 152 ? rlo + 32 : (rlo + 111 < T_TOK ? rlo + 111 : T_TOK)) : T_TOK;
    for (int row = rlo + ((gridDim.x == 256) ? wid : gw); row < rhi; row += ((gridDim.x == 256) ? 8 : nw)) {
        const float* xr = x + (size_t)row * 2048; f32x4 v[8]; float ss = 0.f, amax = 0.f;
#pragma unroll
        for (int i = 0; i < 8; ++i) { v[i] = *(const f32x4*)(xr + i * 256 + lane2 * 4); ss += v[i][0] * v[i][0] + v[i][1] * v[i][1] + v[i][2] * v[i][2] + v[i][3] * v[i][3];
            const f32x4 t = v[i] * gv[i]; amax = fmaxf(amax, fmaxf(fmaxf(fabsf(t[0]), fabsf(t[1])), fmaxf(fabsf(t[2]), fabsf(t[3])))); }
#pragma unroll
        for (int i = 0; i < 8; ++i) { u32x2 xw; xw.x = cvt_pk_bf16(v[i][0], v[i][1]); xw.y = cvt_pk_bf16(v[i][2], v[i][3]); *(u32x2*)(xbp + (size_t)row * 2048 + i * 256 + lane2 * 4) = xw; }
        ss = wave_sum(ss); const float r = rsqrtf(ss * (1.0f / 2048.f) + EPS);
        const float hmx = wave_max(amax) * r; const float hinv = hmx > 0.f ? 127.0f / hmx : 0.f; if (lane2 == 0) sA[row] = hmx > 0.f ? hmx * (1.0f / 127.0f) : 1.0f;
        float ga[8] = {0.f, 0.f, 0.f, 0.f, 0.f, 0.f, 0.f, 0.f};
#pragma unroll
        for (int i = 0; i < 8; ++i) { const f32x4 h = v[i] * r * gv[i];
            const int q0 = __float2int_rn(h[0] * hinv) & 0xff, q1 = __float2int_rn(h[1] * hinv) & 0xff, q2 = __float2int_rn(h[2] * hinv) & 0xff, q3 = __float2int_rn(h[3] * hinv);
            *(int*)(h8 + (size_t)row * 2048 + i * 256 + lane2 * 4) = q0 | (q1 << 8) | (q2 << 16) | (q3 << 24);
#pragma unroll
            for (int j = 0; j < 8; ++j) { const f32x4 wv = *(const LAS f32x4*)(w8t + j * 2048 + i * 256 + lane2 * 4); ga[j] += h[0] * wv[0] + h[1] * wv[1] + h[2] * wv[2] + h[3] * wv[3]; }
            asm volatile("" ::: "memory"); }
#pragma unroll
        for (int j = 0; j < 8; ++j) ga[j] = wave_sum(ga[j]);
        if (lane2 < 8) { float gsel = ga[0];
#pragma unroll
            for (int j = 1; j < 8; ++j) gsel = (lane2 == j) ? ga[j] : gsel;
            const int b = row / SEQ, s = row % SEQ, hh = lane2 & 3;
            if (lane2 < 4) li[(size_t)(b * 4 + hh) * SEQ + s] = gsel + p.in[4][hh];
            else { const float xf = gsel + p.in[5][hh]; lf[(size_t)(b * 4 + hh) * SEQ + s] = fminf(xf, 0.f) - log1pf(__expf(-fabsf(xf))); } }
    }
    __syncthreads();
}

constexpr int PL_CNT = 16, PL_TST = 80, PL_RT2E = 160, PL_NT = 160 + MAXRT, PL_TOKT = 384;
__device__ __forceinline__ g8::MoePlan build_plan(const unsigned* ctl, LAS unsigned char* lds) {
    LAS int* mi = (LAS int*)(lds + LDS_MISC);
    if (threadIdx.x < 64) mi[PL_CNT + threadIdx.x] = (int)__hip_atomic_load(ctl + CW_CNT + threadIdx.x, __ATOMIC_RELAXED, __HIP_MEMORY_SCOPE_AGENT);
    __syncthreads();
    if (threadIdx.x == 0) { int n = 0; for (int e = 0; e < 64; ++e) { mi[PL_TST + e] = n; const int nt = (mi[PL_CNT + e] + 255) >> 8; for (int q = 0; q < nt && n + q < MAXRT; ++q) mi[PL_RT2E + n + q] = e; n += nt; if (n > MAXRT) n = MAXRT; } mi[PL_TST + 64] = n; mi[PL_NT] = n; }
    __syncthreads();
    g8::MoePlan pl; pl.cnt = mi + PL_CNT; pl.tstart = mi + PL_TST; pl.rt2e = mi + PL_RT2E; pl.NT = mi[PL_NT];
    return pl;
}

__device__ __forceinline__ void phase_router(const Ptrs& p, LAS unsigned char* lds, unsigned* ctl, const bool commit) {
    const int tid = threadIdx.x, lane = tid & 63, wid = __builtin_amdgcn_readfirstlane(tid >> 6), g = lane >> 4, c = lane & 15;
    LAS float* LG = (LAS float*)lds;
    LAS float* SS = LG + 64 * 80;
    LAS float* rs = SS + 64;
    const bf16_t* x1 = (const bf16_t*)(p.ws + WS_X1B); const float* gfn = p.in[13];
    const bf16_t* wrh = (const bf16_t*)(p.ws + WS_WRH); const bf16_t* wrl = (const bf16_t*)(p.ws + WS_WRL);
    unsigned char* hf = (unsigned char*)(p.ws + WS_H1); int* tok_of = (int*)(p.ws + WS_TOKOF); int* asg = (int*)(p.ws + WS_ASG); float* gwt = (float*)(p.ws + WS_GW);
    for (int grp = blockIdx.x; grp < T_TOK / 64; grp += gridDim.x) {
        const int t0 = grp * 64;
        __syncthreads();
        f32x4 acc[4][5];
#pragma unroll
        for (int mt = 0; mt < 4; ++mt)
#pragma unroll
            for (int nt = 0; nt < 5; ++nt) acc[mt][nt] = (f32x4){0.f, 0.f, 0.f, 0.f};
        float ssq[4] = {0.f, 0.f, 0.f, 0.f};
        const bf16_t* xr = x1 + (size_t)(t0 + c) * 2048 + wid * 256 + 8 * g;
        const bf16_t* bhp = wrh + (size_t)c * 2048 + wid * 256 + 8 * g; const bf16_t* blp = wrl + (size_t)c * 2048 + wid * 256 + 8 * g;
#pragma unroll 2
        for (int ks = 0; ks < 8; ++ks) {
            bf16x8 ah[4];
#pragma unroll
            for (int mt = 0; mt < 4; ++mt) ah[mt] = *(const bf16x8*)(xr + (size_t)mt * 16 * 2048 + 32 * ks);
            bf16x8 bh[5], bl[5];
#pragma unroll
            for (int nt = 0; nt < 5; ++nt) { bh[nt] = *(const bf16x8*)(bhp + (size_t)nt * 16 * 2048 + 32 * ks); bl[nt] = *(const bf16x8*)(blp + (size_t)nt * 16 * 2048 + 32 * ks); }
#pragma unroll
            for (int mt = 0; mt < 4; ++mt) { u32x4 aw; __builtin_memcpy(&aw, &ah[mt], 16);
#pragma unroll
                for (int q = 0; q < 4; ++q) { const float a = __uint_as_float(aw[q] << 16), b2 = __uint_as_float(aw[q] & 0xffff0000u); ssq[mt] += a * a + b2 * b2; }
#pragma unroll
                for (int nt = 0; nt < 5; ++nt) { acc[mt][nt] = __builtin_amdgcn_mfma_f32_16x16x32_bf16(ah[mt], bh[nt], acc[mt][nt], 0, 0, 0); acc[mt][nt] = __builtin_amdgcn_mfma_f32_16x16x32_bf16(ah[mt], bl[nt], acc[mt][nt], 0, 0, 0); } }
        }
        LAS float* SL = rs + 64;
#pragma unroll
        for (int mt = 0; mt < 4; ++mt) { ssq[mt] += __shfl_xor(ssq[mt], 16); ssq[mt] += __shfl_xor(ssq[mt], 32); }
#pragma unroll
        for (int half = 4; half >= 1; half >>= 1) {
            if (wid >= half && wid < 2 * half) { LAS float* sl = SL + (wid - half) * 84 * 64;
#pragma unroll
                for (int mt = 0; mt < 4; ++mt) { sl[(80 + mt) * 64 + lane] = ssq[mt];
#pragma unroll
                    for (int nt = 0; nt < 5; ++nt)
#pragma unroll
                        for (int r = 0; r < 4; ++r) sl[((mt * 5 + nt) * 4 + r) * 64 + lane] = acc[mt][nt][r]; } }
            __syncthreads();
            if (wid < half) { const LAS float* sl = SL + wid * 84 * 64;
#pragma unroll
                for (int mt = 0; mt < 4; ++mt) { ssq[mt] += sl[(80 + mt) * 64 + lane];
#pragma unroll
                    for (int nt = 0; nt < 5; ++nt)
#pragma unroll
                        for (int r = 0; r < 4; ++r) acc[mt][nt][r] += sl[((mt * 5 + nt) * 4 + r) * 64 + lane]; } }
            __syncthreads();
        }
        if (wid == 0) {
#pragma unroll
            for (int mt = 0; mt < 4; ++mt) { if (g == 0) SS[16 * mt + c] = ssq[mt];
#pragma unroll
                for (int nt = 0; nt < 5; ++nt)
#pragma unroll
                    for (int r = 0; r < 4; ++r) LG[(16 * mt + 4 * g + r) * 80 + 16 * nt + c] = acc[mt][nt][r]; } }
        __syncthreads();
        if (tid < 64) rs[tid] = rsqrtf(SS[tid] * (1.0f / 2048.f) + EPS);
        __syncthreads();
        for (int q = 0; q < 8; q += 2) { const int tok = wid * 8 + q; const size_t row = (size_t)(t0 + tok); const float r0 = rs[tok], r1 = rs[tok + 1]; u32x2 v0[8], v1[8];
#pragma unroll
            for (int i = 0; i < 8; ++i) { v0[i] = *(const u32x2*)(x1 + row * 2048 + i * 256 + lane * 4); v1[i] = *(const u32x2*)(x1 + (row + 1) * 2048 + i * 256 + lane * 4); }
#pragma unroll
            for (int i = 0; i < 8; ++i) { const f32x4 gv = *(const f32x4*)(gfn + i * 256 + lane * 4);
                const f32x4 h0 = (f32x4){__uint_as_float(v0[i].x << 16), __uint_as_float(v0[i].x & 0xffff0000u), __uint_as_float(v0[i].y << 16), __uint_as_float(v0[i].y & 0xffff0000u)} * r0 * gv;
                const f32x4 h1 = (f32x4){__uint_as_float(v1[i].x << 16), __uint_as_float(v1[i].x & 0xffff0000u), __uint_as_float(v1[i].y << 16), __uint_as_float(v1[i].y & 0xffff0000u)} * r1 * gv;
                int w0 = 0, w1 = 0; w0 = __builtin_amdgcn_cvt_pk_fp8_f32(h0[0], h0[1], w0, false); w0 = __builtin_amdgcn_cvt_pk_fp8_f32(h0[2], h0[3], w0, true); w1 = __builtin_amdgcn_cvt_pk_fp8_f32(h1[0], h1[1], w1, false); w1 = __builtin_amdgcn_cvt_pk_fp8_f32(h1[2], h1[3], w1, true);
                *(int*)(hf + row * 2048 + i * 256 + lane * 4) = w0; *(int*)(hf + (row + 1) * 2048 + i * 256 + lane * 4) = w1; } }
        if (tid < 64 && commit) { const int t = t0 + tid; const LAS float* l = LG + tid * 80; const float r = rs[tid];
            float gm = -INFINITY; int gi = 0; float gl[8];
#pragma unroll
            for (int j = 0; j < 8; ++j) { gl[j] = l[j] * r + p.in[15][j]; if (gl[j] > gm) { gm = gl[j]; gi = j; } }
            float gs = 0.f;
#pragma unroll
            for (int j = 0; j < 8; ++j) gs += __expf(gl[j] - gm);
            const float gp = 1.0f / gs;
            float m0 = -INFINITY, m1 = -INFINITY; int i0 = 0, i1 = 0;
            for (int j = 0; j < 8; ++j) { const float e = l[8 + gi * 8 + j] * r + p.in[17][gi * 8 + j]; if (e > m0) { m1 = m0; i1 = i0; m0 = e; i0 = j; } else if (e > m1) { m1 = e; i1 = j; } }
            const float xx = __expf(m1 - m0); const float p0 = 1.0f / (1.0f + xx), p1 = xx / (1.0f + xx);
            const int e0 = gi * 8 + i0, e1 = gi * 8 + i1;
            const int s0 = (int)atomicAdd(ctl + CW_CNT + e0, 1u); tok_of[e0 * ECAP + s0] = t;
            const int s1 = (int)atomicAdd(ctl + CW_CNT + e1, 1u); tok_of[e1 * ECAP + s1] = t;
            asg[2 * t] = (e0 << 16) | s0; asg[2 * t + 1] = (e1 << 16) | s1; gwt[2 * t] = gp * p0; gwt[2 * t + 1] = gp * p1; }
    }
}

__device__ __forceinline__ void phase_combine(const Ptrs& p, const g8::MoePlan& pl) {
    const int lane = threadIdx.x & 63, gw = blockIdx.x * 8 + (threadIdx.x >> 6), nw = gridDim.x * 8;
    const int* asg = (const int*)(p.ws + WS_ASG); const float* gwt = (const float*)(p.ws + WS_GW); const unsigned char* yr = (const unsigned char*)(p.ws + WS_YR); const bf16_t* x1 = (const bf16_t*)(p.ws + WS_X1B); float* out = p.out;
    const int ntok = (T_TOK - gw + nw - 1) / nw;
    int my0 = 0, my1 = 0; float mw0 = 0.f, mw1 = 0.f;
    if (lane < ntok) { const int t = gw + lane * nw; const int a0 = asg[2 * t], a1 = asg[2 * t + 1]; mw0 = gwt[2 * t]; mw1 = gwt[2 * t + 1];
        my0 = pl.tstart[a0 >> 16] * 256 + (a0 & 0xffff); my1 = pl.tstart[a1 >> 16] * 256 + (a1 & 0xffff); }
    for (int k = 0; k < ntok; ++k) { const int t = gw + k * nw;
        const size_t r0 = (size_t)__shfl(my0, k), r1 = (size_t)__shfl(my1, k); const float w0 = __shfl(mw0, k), w1 = __shfl(mw1, k);
        u32x4 y0[2], y1[2], xw[2][2];
#pragma unroll
        for (int i = 0; i < 2; ++i) { const int col = i * 1024 + lane * 16; y0[i] = *(const u32x4*)(yr + r0 * 2048 + col); y1[i] = *(const u32x4*)(yr + r1 * 2048 + col);
            xw[i][0] = *(const u32x4*)(x1 + (size_t)t * 2048 + col); xw[i][1] = *(const u32x4*)(x1 + (size_t)t * 2048 + col + 8); }
#pragma unroll
        for (int i = 0; i < 2; ++i) { const int col = i * 1024 + lane * 16;
#pragma unroll
            for (int q = 0; q < 4; ++q) { const f32x2_t a0 = __builtin_amdgcn_cvt_pk_f32_fp8((int)y0[i][q], false), a1 = __builtin_amdgcn_cvt_pk_f32_fp8((int)y0[i][q], true), b0 = __builtin_amdgcn_cvt_pk_f32_fp8((int)y1[i][q], false), b1 = __builtin_amdgcn_cvt_pk_f32_fp8((int)y1[i][q], true);
                const unsigned xa = xw[i][q >> 1][(q & 1) * 2], xb = xw[i][q >> 1][(q & 1) * 2 + 1]; f32x4 x;
                x[0] = __uint_as_float(xa << 16) + w0 * a0.x + w1 * b0.x; x[1] = __uint_as_float(xa & 0xffff0000u) + w0 * a0.y + w1 * b0.y;
                x[2] = __uint_as_float(xb << 16) + w0 * a1.x + w1 * b1.x; x[3] = __uint_as_float(xb & 0xffff0000u) + w0 * a1.y + w1 * b1.y;
                *(f32x4*)(out + (size_t)t * 2048 + col + 4 * q) = x; } }
    }
}

__device__ __forceinline__ float scan_add64(float v, int lane) {
#pragma unroll
    for (int d = 1; d < 64; d <<= 1) { const float t = __shfl_up(v, d); if (lane >= d) v += t; }
    return v;
}
__device__ __forceinline__ float scan_max64(float v, int lane) {
#pragma unroll
    for (int d = 1; d < 64; d <<= 1) { const float t = __shfl_up(v, d); if (lane >= d) v = fmaxf(v, t); }
    return v;
}
__device__ __forceinline__ void tr8_store(const unsigned (&v)[8][4], bf16_t* dst0, size_t pitch) {
#pragma unroll
    for (int e = 0; e < 8; ++e) { const int q = e >> 1; u32x4 o;
        if (e & 1) { o.x = (v[0][q] >> 16) | (v[1][q] & 0xffff0000u); o.y = (v[2][q] >> 16) | (v[3][q] & 0xffff0000u); o.z = (v[4][q] >> 16) | (v[5][q] & 0xffff0000u); o.w = (v[6][q] >> 16) | (v[7][q] & 0xffff0000u); }
        else { o.x = (v[0][q] & 0xffffu) | (v[1][q] << 16); o.y = (v[2][q] & 0xffffu) | (v[3][q] << 16); o.z = (v[4][q] & 0xffffu) | (v[5][q] << 16); o.w = (v[6][q] & 0xffffu) | (v[7][q] << 16); }
        *(u32x4*)(dst0 + (size_t)e * pitch) = o; }
}
__device__ __forceinline__ void phase_prep(const Ptrs& p) {
    const int tid = threadIdx.x, lane = tid & 63, wid = tid >> 6;
    const bf16_t* z2 = (const bf16_t*)(p.ws + WS_Z2);
    bf16_t* qc = (bf16_t*)(p.ws + WS_QC); bf16_t* kc = (bf16_t*)(p.ws + WS_KC); bf16_t* kT = (bf16_t*)(p.ws + WS_KT); bf16_t* vT = (bf16_t*)(p.ws + WS_VT);
    bf16_t* aqr = (bf16_t*)(p.ws + WS_AQR); bf16_t* akr = (bf16_t*)(p.ws + WS_AKR); bf16_t* avT = (bf16_t*)(p.ws + WS_AVT);
    for (int item = blockIdx.x; item < T_TOK / 64; item += gridDim.x) {
        const int b = item >> 5, chunk = item & 31, s0 = chunk * 64; const size_t t0 = (size_t)item * 64;
        unsigned vv[2][8][4];
        { const int cg = tid & 127, tq = tid >> 7, ch0 = cg * 8;
#pragma unroll
          for (int oct = 0; oct < 2; ++oct)
#pragma unroll
              for (int tt = 0; tt < 8; ++tt) { const u32x4 x = *(const u32x4*)(z2 + (t0 + tq * 16 + oct * 8 + tt) * NZ + ZV + ch0); vv[oct][tt][0] = x[0]; vv[oct][tt][1] = x[1]; vv[oct][tt][2] = x[2]; vv[oct][tt][3] = x[3]; } }
        if (wid < 4) { const size_t gi = (size_t)(b * 4 + wid) * SEQ + s0 + lane; const float liv = ((const float*)(p.ws + WS_LI))[gi], lfv = ((const float*)(p.ws + WS_LF))[gi];
            const float bc = scan_add64(lfv, lane); const float u = liv - bc; const float pm = scan_max64(u, lane);
            ((float*)(p.ws + WS_BC))[gi] = bc; ((float*)(p.ws + WS_UU))[gi] = u; ((float*)(p.ws + WS_PM))[gi] = pm; }
        { int tz = tid; asm volatile("" : "+v"(tz)); const int cg = tz & 127, tq = tz >> 7, ch0 = cg * 8, hh = ch0 >> 8, dv0 = ch0 & 255;
#pragma unroll
          for (int oct = 0; oct < 2; ++oct) tr8_store(vv[oct], vT + (((size_t)(b * 4 + hh) * 32 + chunk) * 256 + dv0) * 64 + tq * 16 + oct * 8, 64); }
        { int tz = tid; asm volatile("" : "+v"(tz)); const int cg = tz & 255, th = tz >> 8, ch0 = cg * 8; const float* cw = p.in[3];
          float w[4][8];
#pragma unroll
          for (int j = 0; j < 4; ++j) { const f32x4 a = *(const f32x4*)(cw + j * 2048 + ch0), bq = *(const f32x4*)(cw + j * 2048 + ch0 + 4);
#pragma unroll
              for (int e = 0; e < 4; ++e) { w[j][e] = a[e]; w[j][4 + e] = bq[e]; } }
          float x0[8], x1[8], x2[8];
          const int sfirst = s0 + th * 32;
          { u32x4 hv[3];
#pragma unroll
            for (int d = 0; d < 3; ++d) hv[d] = (sfirst - 3 + d >= 0) ? *(const u32x4*)(z2 + (t0 + th * 32 - 3 + d) * NZ + ch0) : (u32x4){0u, 0u, 0u, 0u};
#pragma unroll
            for (int q = 0; q < 4; ++q) { x0[2 * q] = __uint_as_float(hv[0][q] << 16); x0[2 * q + 1] = __uint_as_float(hv[0][q] & 0xffff0000u); x1[2 * q] = __uint_as_float(hv[1][q] << 16); x1[2 * q + 1] = __uint_as_float(hv[1][q] & 0xffff0000u);
                x2[2 * q] = __uint_as_float(hv[2][q] << 16); x2[2 * q + 1] = __uint_as_float(hv[2][q] & 0xffff0000u); } }
          const bool isk = ch0 >= 1024; const int hh = (ch0 & 1023) >> 8, dk0 = ch0 & 255;
          for (int bt = 0; bt < 2; ++bt) { u32x4 raw[16];
#pragma unroll
              for (int tt = 0; tt < 16; ++tt) raw[tt] = *(const u32x4*)(z2 + (t0 + th * 32 + bt * 16 + tt) * NZ + ch0);
#pragma unroll
              for (int oc = 0; oc < 2; ++oc) { unsigned yo[8][4];
#pragma unroll
                  for (int tt = 0; tt < 8; ++tt) { const size_t t = t0 + th * 32 + bt * 16 + oc * 8 + tt; const u32x4 v = raw[oc * 8 + tt]; float f[8], y[8];
#pragma unroll
                      for (int q = 0; q < 4; ++q) { f[2 * q] = __uint_as_float(v[q] << 16); f[2 * q + 1] = __uint_as_float(v[q] & 0xffff0000u); }
#pragma unroll
                      for (int e = 0; e < 8; ++e) { float a = w[0][e] * x0[e] + w[1][e] * x1[e] + w[2][e] * x2[e] + w[3][e] * f[e]; a = a * frcp(1.0f + __expf(-a)); if (isk) a *= 0.0625f; y[e] = a; x0[e] = x1[e]; x1[e] = x2[e]; x2[e] = f[e]; }
                      u32x4 o; o.x = cvt_pk_bf16(y[0], y[1]); o.y = cvt_pk_bf16(y[2], y[3]); o.z = cvt_pk_bf16(y[4], y[5]); o.w = cvt_pk_bf16(y[6], y[7]);
                      *(u32x4*)((isk ? kc : qc) + t * 1024 + (ch0 & 1023)) = o; yo[tt][0] = o.x; yo[tt][1] = o.y; yo[tt][2] = o.z; yo[tt][3] = o.w; }
                  (void)yo; } }
        }
        unsigned av[8][4];
        if (tid < 256) { int tz = tid; asm volatile("" : "+v"(tz)); const int cg = tz & 31, tq = tz >> 5, ch0 = cg * 8;
#pragma unroll
            for (int tt = 0; tt < 8; ++tt) { const u32x4 x = *(const u32x4*)(z2 + (t0 + tq * 8 + tt) * NZ + ZAV + ch0); av[tt][0] = x[0]; av[tt][1] = x[1]; av[tt][2] = x[2]; av[tt][3] = x[3]; } }
        { int lz = lane; asm volatile("" : "+v"(lz)); const int i = lz & 31; const float freq = exp2f(-(float)i * (13.287712379549449f / 32.0f));
          const float gq = p.in[7][lz], gk = p.in[8][lz];
          for (int tp = 0; tp < 4; ++tp) { float v[2][20], ss[2][20];
#pragma unroll
              for (int u = 0; u < 2; ++u)
#pragma unroll
                  for (int hx = 0; hx < 20; ++hx) { v[u][hx] = bf2f(z2[(t0 + wid * 8 + tp * 2 + u) * NZ + ZAQ + hx * 64 + lz]); ss[u][hx] = v[u][hx] * v[u][hx]; }
#pragma unroll
              for (int o = 32; o >= 1; o >>= 1) {
#pragma unroll
                  for (int u = 0; u < 2; ++u)
#pragma unroll
                      for (int hx = 0; hx < 20; ++hx) ss[u][hx] += __shfl_xor(ss[u][hx], o); }
#pragma unroll
              for (int u = 0; u < 2; ++u) { const int tok = wid * 8 + tp * 2 + u; const size_t t = t0 + tok; const float ang = (float)(s0 + tok) * freq; const float cs = __cosf(ang), sn = __sinf(ang);
#pragma unroll
                  for (int hx = 0; hx < 20; ++hx) { const float y = v[u][hx] * rsqrtf(ss[u][hx] * (1.0f / 64.f) + EPS) * (hx < 16 ? gq : gk); const float other = __shfl_xor(y, 32);
                      const float o = (lz < 32) ? (y * cs - other * sn) : (y * cs + other * sn);
                      if (hx < 16) aqr[t * 1024 + hx * 64 + lz] = f2bf(o * 0.125f); else akr[t * 256 + (hx - 16) * 64 + lz] = f2bf(o); } } } }
        if (tid < 256) { int tz = tid; asm volatile("" : "+v"(tz)); const int cg = tz & 31, tq = tz >> 5, ch0 = cg * 8, kvh = ch0 >> 6, dh0 = ch0 & 63;
            tr8_store(av, avT + ((size_t)(b * 4 + kvh) * 64 + dh0) * 2048 + s0 + tq * 8, 2048); }
    }
}

__device__ __forceinline__ void phase_attn(const Ptrs& p, LAS unsigned char* lds) {
    const int tid = threadIdx.x, lane = tid & 63, wid = tid >> 6, g = lane >> 4, c = lane & 15;
    const bf16_t* aqr = (const bf16_t*)(p.ws + WS_AQR); const bf16_t* akr = (const bf16_t*)(p.ws + WS_AKR); const bf16_t* avT = (const bf16_t*)(p.ws + WS_AVT); bf16_t* ha = (bf16_t*)(p.ws + WS_HA);
    constexpr int KP = 144, VP = 528;
    LAS unsigned char* Kl = lds; LAS unsigned char* Vl = lds + 256 * KP;
    for (int unit = blockIdx.x; unit < 512; unit += gridDim.x) {
        const int b = unit >> 6, kvh = (unit >> 4) & 3, blk = unit & 15; const int sblk = blk * 128, kb0 = sblk - 128;
        __syncthreads();
#pragma unroll
        for (int q = 0; q < 4; ++q) { const int idx = tid + 512 * q, row = idx >> 3, ch = idx & 7; const int pos = kb0 + row; u32x4 v = (u32x4){0u, 0u, 0u, 0u};
            if (pos >= 0) v = *(const u32x4*)(akr + ((size_t)(b * 2048 + pos)) * 256 + kvh * 64 + ch * 8);
            *(LAS u32x4*)(Kl + row * KP + ch * 16) = v; }
#pragma unroll
        for (int q = 0; q < 4; ++q) { const int idx = tid + 512 * q, row = idx >> 5, ch = idx & 31; const int pos0 = kb0 + ch * 8; u32x4 v = (u32x4){0u, 0u, 0u, 0u};
            if (pos0 >= 0) v = *(const u32x4*)(avT + ((size_t)(b * 4 + kvh) * 64 + row) * 2048 + pos0);
            *(LAS u32x4*)(Vl + row * VP + ch * 16) = v; }
        __syncthreads();
        const int head = kvh * 4 + (wid >> 1), qh = wid & 1; const float sink = p.in[9][head];
        for (int qt = 0; qt < 4; ++qt) {
            const int q0 = qh * 64 + qt * 16; const size_t tokq = (size_t)b * 2048 + sblk + q0 + c;
            bf16x8 bq[2];
#pragma unroll
            for (int ks = 0; ks < 2; ++ks) bq[ks] = *(const bf16x8*)(aqr + tokq * 1024 + head * 64 + 8 * g + 32 * ks);
            const int kbase = (q0 >> 4) < 6 ? (q0 >> 4) : 6;
            f32x4 sacc[10];
#pragma unroll
            for (int i = 0; i < 10; ++i) { sacc[i] = (f32x4){0.f, 0.f, 0.f, 0.f};
#pragma unroll
                for (int ks = 0; ks < 2; ++ks) { const bf16x8 ka = *(const LAS bf16x8*)(Kl + (16 * (kbase + i) + c) * KP + (8 * g + 32 * ks) * 2);
                    sacc[i] = __builtin_amdgcn_mfma_f32_16x16x32_bf16(ka, bq[ks], sacc[i], 0, 0, 0); } }
            const int ql = q0 + c; float mloc = -INFINITY;
#pragma unroll
            for (int i = 0; i < 10; ++i)
#pragma unroll
                for (int r = 0; r < 4; ++r) { const int col = 16 * (kbase + i) + 4 * g + r; const bool ok = (col >= ql + 1) && (col <= ql + 128) && (kb0 + col >= 0);
                    const float s = ok ? sacc[i][r] : -INFINITY; sacc[i][r] = s; mloc = fmaxf(mloc, s); }
            mloc = fmaxf(mloc, __shfl_xor(mloc, 16)); mloc = fmaxf(mloc, __shfl_xor(mloc, 32)); const float mx = fmaxf(mloc, sink);
            float lsum = 0.f;
#pragma unroll
            for (int i = 0; i < 10; ++i)
#pragma unroll
                for (int r = 0; r < 4; ++r) { const float pv = __expf(sacc[i][r] - mx); sacc[i][r] = pv; lsum += pv; }
            lsum += __shfl_xor(lsum, 16); lsum += __shfl_xor(lsum, 32); const float inv = 1.0f / (lsum + __expf(sink - mx));
            f32x4 oacc[4];
#pragma unroll
            for (int mt = 0; mt < 4; ++mt) oacc[mt] = (f32x4){0.f, 0.f, 0.f, 0.f};
#pragma unroll
            for (int k2 = 0; k2 < 5; ++k2) { u32x4 pw; pw.x = cvt_pk_bf16(sacc[2 * k2][0] * inv, sacc[2 * k2][1] * inv); pw.y = cvt_pk_bf16(sacc[2 * k2][2] * inv, sacc[2 * k2][3] * inv);
                pw.z = cvt_pk_bf16(sacc[2 * k2 + 1][0] * inv, sacc[2 * k2 + 1][1] * inv); pw.w = cvt_pk_bf16(sacc[2 * k2 + 1][2] * inv, sacc[2 * k2 + 1][3] * inv);
                bf16x8 pb; __builtin_memcpy(&pb, &pw, 16);
#pragma unroll
                for (int mt = 0; mt < 4; ++mt) { const LAS unsigned char* vr = Vl + (16 * mt + c) * VP + (16 * (kbase + 2 * k2) + 4 * g) * 2;
                    const u32x2 lo = *(const LAS u32x2*)vr, hi = *(const LAS u32x2*)(vr + 32); u32x4 vw; vw.x = lo.x; vw.y = lo.y; vw.z = hi.x; vw.w = hi.y; bf16x8 va; __builtin_memcpy(&va, &vw, 16);
                    oacc[mt] = __builtin_amdgcn_mfma_f32_16x16x32_bf16(va, pb, oacc[mt], 0, 0, 0); } }
#pragma unroll
            for (int mt = 0; mt < 4; ++mt) { u32x2 o; o.x = pk_bf16_sw(oacc[mt][0], oacc[mt][1]); o.y = pk_bf16_sw(oacc[mt][2], oacc[mt][3]);
                *(u32x2*)(ha + tokq * 1024 + head * 64 + 16 * mt + 4 * g) = o; }
        }
    }
}

__device__ __forceinline__ bf16x8 scale_frag(bf16x8 f, const f32x4 wa, const f32x4 wb) {
    u32x4 w; __builtin_memcpy(&w, &f, 16); u32x4 o;
    o.x = cvt_pk_bf16(__uint_as_float(w.x << 16) * wa[0], __uint_as_float(w.x & 0xffff0000u) * wa[1]);
    o.y = cvt_pk_bf16(__uint_as_float(w.y << 16) * wa[2], __uint_as_float(w.y & 0xffff0000u) * wa[3]);
    o.z = cvt_pk_bf16(__uint_as_float(w.z << 16) * wb[0], __uint_as_float(w.z & 0xffff0000u) * wb[1]);
    o.w = cvt_pk_bf16(__uint_as_float(w.w << 16) * wb[2], __uint_as_float(w.w & 0xffff0000u) * wb[3]);
    bf16x8 r; __builtin_memcpy(&r, &o, 16); return r;
}
__device__ __forceinline__ void phase_mlstm(const Ptrs& p, LAS unsigned char* lds) {
    const int tid = threadIdx.x, lane = tid & 63, wid = __builtin_amdgcn_readfirstlane(tid >> 6), g = lane >> 4, c = lane & 15;
    constexpr int QP = 528, PP = 144, CP = 528;
    constexpr int OFF_Q = 0, OFF_K = 64 * QP, OFF_P = 2 * 64 * QP, OFF_CT = OFF_P + 64 * PP, CT_BYTES = 48 * CP, OFF_TAB = OFF_CT + 2 * CT_BYTES, TAB_BYTES = 2048, OFF_VS = OFF_TAB + 2 * TAB_BYTES, VSP = 144;
    const bf16_t* qc = (const bf16_t*)(p.ws + WS_QC); const bf16_t* kc = (const bf16_t*)(p.ws + WS_KC); const bf16_t* kT = (const bf16_t*)(p.ws + WS_KT); const bf16_t* vT = (const bf16_t*)(p.ws + WS_VT);
    const float* bcg = (const float*)(p.ws + WS_BC); const float* uug = (const float*)(p.ws + WS_UU); const float* pmg = (const float*)(p.ws + WS_PM); bf16_t* hraw = (bf16_t*)(p.ws + WS_HRAW);
    for (int unit = blockIdx.x; unit < 256; unit += gridDim.x) {
        const int js = (unit >> 3) & 7, bh = (unit & 7) + 8 * (unit >> 6), b = bh >> 2, h = bh & 3; const size_t tok0 = (size_t)b * SEQ;
        __syncthreads();
        for (int i = tid; i < CT_BYTES / 16; i += NTHR) *(LAS u32x4*)(lds + OFF_CT + i * 16) = (u32x4){0u, 0u, 0u, 0u};
        for (int i = tid; i < 48 * VSP / 16; i += NTHR) *(LAS u32x4*)(lds + OFF_VS + i * 16) = (u32x4){0u, 0u, 0u, 0u};
        f32x4 cacc[2][3];
#pragma unroll
        for (int x = 0; x < 2; ++x)
#pragma unroll
            for (int t3 = 0; t3 < 3; ++t3) cacc[x][t3] = (f32x4){0.f, 0.f, 0.f, 0.f};
        float mcar = 0.f;
        u32x4 pq[4], pk[4];
        bf16x8 kTf[2][2], vTh[2], vThn[2]; u32x2 vsr, vsn;
        float tbc = 0.f, tuu = 0.f, tpm = 0.f;
#define ML_LOAD_QK(ch) do { _Pragma("unroll") for (int q = 0; q < 4; ++q) { const int idx = tid + NTHR * q, row = idx >> 5, cc = idx & 31; const size_t off = (tok0 + (size_t)(ch) * 64 + row) * 1024 + h * 256 + cc * 8; \
            pq[q] = *(const u32x4*)(qc + off); pk[q] = *(const u32x4*)(kc + off); } } while (0)
#define ML_STORE_QK() do { _Pragma("unroll") for (int q = 0; q < 4; ++q) { const int idx = tid + NTHR * q, row = idx >> 5, cc = idx & 31; \
            *(LAS u32x4*)(lds + OFF_Q + row * QP + cc * 16) = pq[q]; *(LAS u32x4*)(lds + OFF_K + row * QP + cc * 16) = pk[q]; } } while (0)
#define ML_LOAD_T(ch, VH, VR) do { const size_t cb = ((size_t)bh * 32 + (ch)) * 256; \
            _Pragma("unroll") for (int k2 = 0; k2 < 2; ++k2) VH[k2] = *(const bf16x8*)(vT + (cb + 32 * js + 16 * (wid & 1) + c) * 64 + 8 * g + 32 * k2); \
            VR = *(const u32x2*)(vT + (cb + 32 * js + (tid >> 4)) * 64 + 4 * (tid & 15)); } while (0)
#define ML_TABLES(ch) do { if (wid == 0) { LAS float* tb = (LAS float*)(lds + OFF_TAB + ((ch) & 1) * TAB_BYTES); \
            const float bcum = tbc, u = tuu, pm = tpm; \
            const float mt = bcum + fmaxf(mcar, pm); const float bL = __shfl(bcum, 63), pmL = __shfl(pm, 63); const float mnew = fmaxf(bL + mcar, bL + pmL); \
            tb[lane] = bcum - mt; tb[64 + lane] = u; tb[128 + lane] = __expf(bcum + mcar - mt); tb[192 + lane] = __expf(-mt); tb[256 + lane] = __expf(bL + u - mnew); \
            if (lane == 0) tb[320] = __expf(bL + mcar - mnew); mcar = mnew; } } while (0)
#define ML_LOAD_G(ch) do { if (wid == 0) { const size_t gi = (size_t)bh * SEQ + (size_t)(ch) * 64 + lane; tbc = bcg[gi]; tuu = uug[gi]; tpm = pmg[gi]; } } while (0)
        ML_LOAD_G(0);
        ML_LOAD_QK(0); ML_LOAD_T(0, vTh, vsr); ML_STORE_QK(); ML_TABLES(0);
        ML_LOAD_G(1);
        ML_LOAD_QK(1);
        __syncthreads();
        for (int ch = 0; ch < 32; ++ch) {
            const LAS float* tb = (const LAS float*)(lds + OFF_TAB + (ch & 1) * TAB_BYTES);
            LAS unsigned char* CTcur = lds + OFF_CT + (ch & 1) * CT_BYTES; LAS unsigned char* CTnxt = lds + OFF_CT + ((ch + 1) & 1) * CT_BYTES;
            const int tm = wid >> 1, th = wid & 1;
            bf16x8 qa[8];
#pragma unroll
            for (int ks = 0; ks < 8; ++ks) qa[ks] = *(const LAS bf16x8*)(lds + OFF_Q + (16 * tm + c) * QP + (8 * g + 32 * ks) * 2);
            f32x4 sacc[2];
#pragma unroll
            for (int n = 0; n < 2; ++n) { sacc[n] = (f32x4){0.f, 0.f, 0.f, 0.f};
#pragma unroll
                for (int ks = 0; ks < 8; ++ks) { const bf16x8 kb = *(const LAS bf16x8*)(lds + OFF_K + (16 * (2 * th + n) + c) * QP + (8 * g + 32 * ks) * 2);
                    sacc[n] = __builtin_amdgcn_mfma_f32_16x16x32_bf16(qa[ks], kb, sacc[n], 0, 0, 0); } }
#pragma unroll
            for (int x = 0; x < 2; ++x)
#pragma unroll
                for (int k2 = 0; k2 < 2; ++k2) { typedef short s16x4 __attribute__((ext_vector_type(4)));
                    const LAS unsigned char* ka = lds + OFF_K + (32 * k2 + 8 * g + (c >> 2)) * QP + (16 * (2 * wid + x) + 4 * (c & 3)) * 2;
                    const s16x4 lo = __builtin_amdgcn_ds_read_tr16_b64_v4i16((LAS s16x4*)ka), hi = __builtin_amdgcn_ds_read_tr16_b64_v4i16((LAS s16x4*)(ka + 4 * QP));
                    kTf[x][k2] = (bf16x8){lo[0], lo[1], lo[2], lo[3], hi[0], hi[1], hi[2], hi[3]}; }
            { const f32x4 bm4 = *(const LAS f32x4*)(tb + 16 * tm + 4 * g);
#pragma unroll
              for (int n = 0; n < 2; ++n) { const int s = 16 * (2 * th + n) + c; const float us = tb[64 + s];
#pragma unroll
                  for (int r = 0; r < 4; ++r) { const int t = 16 * tm + 4 * g + r; const float pv = (s <= t) ? sacc[n][r] * __expf(bm4[r] + us) : 0.f;
                      *(LAS bf16_t*)(lds + OFF_P + t * PP + s * 2) = f2bf(pv); } } }
            { const f32x4 wk4 = *(const LAS f32x4*)(tb + 256 + 4 * (tid & 15));
              u32x2 o; o.x = cvt_pk_bf16(__uint_as_float(vsr.x << 16) * wk4[0], __uint_as_float(vsr.x & 0xffff0000u) * wk4[1]); o.y = cvt_pk_bf16(__uint_as_float(vsr.y << 16) * wk4[2], __uint_as_float(vsr.y & 0xffff0000u) * wk4[3]);
              *(LAS u32x2*)(lds + OFF_VS + (tid >> 4) * VSP + 8 * (tid & 15)) = o;
              if (tid < 16) { u32x2 e; e.x = cvt_pk_bf16(wk4[0], wk4[1]); e.y = cvt_pk_bf16(wk4[2], wk4[3]); *(LAS u32x2*)(lds + OFF_VS + 32 * VSP + 8 * tid) = e; } }
            LDS_BARRIER();
            if (ch + 1 < 32) ML_LOAD_T(ch + 1, vThn, vsn);
            { f32x4 hacc0 = (f32x4){0.f, 0.f, 0.f, 0.f}, hacc1 = (f32x4){0.f, 0.f, 0.f, 0.f};
#pragma unroll
              for (int ks = 0; ks < 8; ++ks) { const bf16x8 cb0 = *(const LAS bf16x8*)(CTcur + (16 * th + c) * CP + (8 * g + 32 * ks) * 2); const bf16x8 cb1 = *(const LAS bf16x8*)(CTcur + (32 + c) * CP + (8 * g + 32 * ks) * 2);
                  hacc0 = __builtin_amdgcn_mfma_f32_16x16x32_bf16(qa[ks], cb0, hacc0, 0, 0, 0); hacc1 = __builtin_amdgcn_mfma_f32_16x16x32_bf16(qa[ks], cb1, hacc1, 0, 0, 0); }
              const f32x4 wi4 = *(const LAS f32x4*)(tb + 128 + 16 * tm + 4 * g); hacc0 *= wi4; hacc1 *= wi4;
              const unsigned onew = (c == 0) ? 0x3f803f80u : 0u; const u32x4 ow = (u32x4){onew, onew, onew, onew}; bf16x8 ones; __builtin_memcpy(&ones, &ow, 16);
#pragma unroll
              for (int k2 = 0; k2 < 2; ++k2) { const bf16x8 pa = *(const LAS bf16x8*)(lds + OFF_P + (16 * tm + c) * PP + (8 * g + 32 * k2) * 2);
                  hacc0 = __builtin_amdgcn_mfma_f32_16x16x32_bf16(pa, vTh[k2], hacc0, 0, 0, 0); hacc1 = __builtin_amdgcn_mfma_f32_16x16x32_bf16(pa, ones, hacc1, 0, 0, 0); }
              const f32x4 ei4 = *(const LAS f32x4*)(tb + 192 + 16 * tm + 4 * g);
#pragma unroll
              for (int r = 0; r < 4; ++r) { const float qn = __shfl(hacc1[r], g * 16); const float den = fmaxf(fabsf(qn), ei4[r]);
                  hraw[(tok0 + (size_t)ch * 64 + 16 * tm + 4 * g + r) * 1024 + h * 256 + 32 * js + 16 * th + c] = f2bf(hacc0[r] * frcp(den)); } }
            { const float dec = tb[320]; bf16x8 vs[3][2];
#pragma unroll
              for (int t3 = 0; t3 < 3; ++t3)
#pragma unroll
                  for (int k2 = 0; k2 < 2; ++k2) vs[t3][k2] = *(const LAS bf16x8*)(lds + OFF_VS + (16 * t3 + c) * VSP + (8 * g + 32 * k2) * 2);
#pragma unroll
              for (int x = 0; x < 2; ++x)
#pragma unroll
                  for (int t3 = 0; t3 < 3; ++t3) { cacc[x][t3] *= dec;
#pragma unroll
                      for (int k2 = 0; k2 < 2; ++k2) cacc[x][t3] = __builtin_amdgcn_mfma_f32_16x16x32_bf16(kTf[x][k2], vs[t3][k2], cacc[x][t3], 0, 0, 0);
                      u32x2 o; o.x = pk_bf16_sw(cacc[x][t3][0], cacc[x][t3][1]); o.y = pk_bf16_sw(cacc[x][t3][2], cacc[x][t3][3]);
                      *(LAS u32x2*)(CTnxt + (16 * t3 + c) * CP + (16 * (2 * wid + x) + 4 * g) * 2) = o; } }
            if (ch + 1 < 32) { ML_STORE_QK(); ML_TABLES(ch + 1);
                vTh[0] = vThn[0]; vTh[1] = vThn[1]; vsr = vsn;
                if (ch + 2 < 32) { ML_LOAD_G(ch + 2); ML_LOAD_QK(ch + 2); } }
            LDS_BARRIER();
        }
#undef ML_LOAD_QK
#undef ML_STORE_QK
#undef ML_LOAD_T
#undef ML_TABLES
#undef ML_LOAD_G
    }
}

__device__ __forceinline__ void phase_hmpost(const Ptrs& p) {
    const int lane = threadIdx.x & 63, gw = blockIdx.x * 8 + (threadIdx.x >> 6), nw = gridDim.x * 8;
    const bf16_t* hraw = (const bf16_t*)(p.ws + WS_HRAW); const bf16_t* z2 = (const bf16_t*)(p.ws + WS_Z2); bf16_t* hm = (bf16_t*)(p.ws + WS_HM); const float* gm = p.in[6];
    f32x4 gv[4];
#pragma unroll
    for (int h = 0; h < 4; ++h) gv[h] = *(const f32x4*)(gm + h * 256 + lane * 4);
    for (int tt = gw; tt < T_TOK; tt += 2 * nw) {
        f32x4 v[2][4]; u32x2 mo[2][4]; float ss[2][4];
#pragma unroll
        for (int u = 0; u < 2; ++u) { const size_t t = (size_t)(tt + u * nw);
#pragma unroll
            for (int h = 0; h < 4; ++h) { const u32x2 hv = *(const u32x2*)(hraw + t * 1024 + h * 256 + lane * 4); v[u][h] = (f32x4){__uint_as_float(hv.x << 16), __uint_as_float(hv.x & 0xffff0000u), __uint_as_float(hv.y << 16), __uint_as_float(hv.y & 0xffff0000u)};
                mo[u][h] = *(const u32x2*)(z2 + t * NZ + ZO + h * 256 + lane * 4); } }
#pragma unroll
        for (int u = 0; u < 2; ++u)
#pragma unroll
            for (int h = 0; h < 4; ++h) ss[u][h] = v[u][h][0] * v[u][h][0] + v[u][h][1] * v[u][h][1] + v[u][h][2] * v[u][h][2] + v[u][h][3] * v[u][h][3];
#pragma unroll
        for (int o = 32; o >= 1; o >>= 1) {
#pragma unroll
            for (int u = 0; u < 2; ++u)
#pragma unroll
                for (int h = 0; h < 4; ++h) ss[u][h] += __shfl_xor(ss[u][h], o); }
#pragma unroll
        for (int u = 0; u < 2; ++u) { const size_t t = (size_t)(tt + u * nw);
#pragma unroll
            for (int h = 0; h < 4; ++h) { const float r = rsqrtf(ss[u][h] * (1.0f / 256.f) + EPS);
                const float o0 = v[u][h][0] * r * gv[h][0] * sigmoidf_(__uint_as_float(mo[u][h].x << 16)), o1 = v[u][h][1] * r * gv[h][1] * sigmoidf_(__uint_as_float(mo[u][h].x & 0xffff0000u));
                const float o2 = v[u][h][2] * r * gv[h][2] * sigmoidf_(__uint_as_float(mo[u][h].y << 16)), o3 = v[u][h][3] * r * gv[h][3] * sigmoidf_(__uint_as_float(mo[u][h].y & 0xffff0000u));
                u32x2 o; o.x = cvt_pk_bf16(o0, o1); o.y = cvt_pk_bf16(o2, o3); *(u32x2*)(hm + t * 1024 + h * 256 + lane * 4) = o; } } }
}

struct Args { Ptrs p; int ph_lo, ph_hi, bar_region, pad; };
__global__ void __launch_bounds__(NTHR, 2) mega(Args args) {
    extern __shared__ __attribute__((aligned(16))) unsigned char lds_raw[];
    LAS unsigned char* lds = (LAS unsigned char*)lds_raw;
    const Ptrs& p = args.p;
    volatile LAS unsigned* xbw = (volatile LAS unsigned*)(lds + LDS_MISC);
    if (threadIdx.x < 4) xbw[threadIdx.x] = 0u;
    __syncthreads();
    unsigned* ctl = (unsigned*)(p.ws + WS_CTL);
    XcdBarrier bar = xcd_barrier_post(ctl + CW_BAR + args.bar_region * XCD_BAR_WORDS, xbw);
    const int lo = args.ph_lo, hi = args.ph_hi; const int G = (int)gridDim.x, c = (int)blockIdx.x;
#define IN(k) (lo <= (k) && (k) < hi)
#define SEAM(k) do { if (IN(k) && IN((k) + 1)) xcd_barrier(bar); } while (0)
    if (IN(0)) { phase0(p, lds); if constexpr ((DBL_MASK >> 0) & 1) phase0(p, lds); }
    SEAM(0);
    if (IN(1)) {
        const int grp = (c >> 3) & 1, nsplit = grp == 0 ? 0 : 1000;
        g8::PolDenseI8 pol{(const signed char*)(p.ws + WS_H1), (const signed char*)(p.ws + WS_WTIN), (bf16_t*)(p.ws + WS_Z2), (const float*)(p.ws + WS_SA), (const float*)(p.ws + WS_SB), T_TOK, NZ, 2048, NZ, G, c, 0, nsplit};
        g8::gemm_phase(lds, pol);
        cvt_experts(p, lds); if constexpr ((DBL_MASK >> 11) & 1) cvt_experts(p, lds);
        pol.ilo = nsplit; pol.ihi = 100000;
        g8::gemm_phase(lds, pol); if constexpr ((DBL_MASK >> 1) & 1) { pol.ilo = 0; g8::gemm_phase(lds, pol); } }
    SEAM(1);
    if (IN(2)) { phase_prep(p); if constexpr ((DBL_MASK >> 2) & 1) phase_prep(p); }
    SEAM(2);
    if (IN(3)) { if (p.mix_mask & 2) { phase_mlstm(p, lds); if constexpr ((DBL_MASK >> 3) & 1) phase_mlstm(p, lds); } if (p.mix_mask & 1) { phase_attn(p, lds); if constexpr ((DBL_MASK >> 4) & 1) phase_attn(p, lds); } }
    SEAM(3);
    if (IN(4)) { phase_hmpost(p); if constexpr ((DBL_MASK >> 7) & 1) phase_hmpost(p); }
    SEAM(4);
    if (IN(5)) { g8::PolProj pol{(const bf16_t*)(p.ws + WS_HM), (const bf16_t*)(p.ws + WS_HA), (const bf16_t*)(p.ws + WS_WTPM), (const bf16_t*)(p.ws + WS_WTPA), (const bf16_t*)(p.ws + WS_Z2), (bf16_t*)(p.ws + WS_MIXED), 1024, G, c};
        g8::gemm_phase(lds, pol); if constexpr ((DBL_MASK >> 5) & 1) g8::gemm_phase(lds, pol); }
    SEAM(5);
    if (IN(6)) { g8::PolDenseBf16Res pol{(const bf16_t*)(p.ws + WS_MIXED), (const bf16_t*)(p.ws + WS_WTOUT), (const bf16_t*)(p.ws + WS_XB), (bf16_t*)(p.ws + WS_X1B), T_TOK, 2048, 2048, 2048, G, c};
        g8::gemm_phase(lds, pol); if constexpr ((DBL_MASK >> 6) & 1) g8::gemm_phase(lds, pol); }
    SEAM(6);
    if (IN(7)) { if constexpr ((DBL_MASK >> 10) & 1) phase_router(p, lds, ctl, false); phase_router(p, lds, ctl, true); }
    SEAM(7);
    if (IN(8) || IN(9) || IN(10)) {
        const g8::MoePlan pl = build_plan(ctl, lds);
        if (IN(8)) {
            LAS int* tokT = (LAS int*)(lds + LDS_MISC) + PL_TOKT; const int* tok_of = (const int*)(p.ws + WS_TOKOF);
            for (int i = 0; i < 5; ++i) { const int L = i * G + c; if (L < pl.NT * 6) { const int rt = L / 6, e = pl.rt2e[rt], s0 = (rt - pl.tstart[e]) * 256, ce = pl.cnt[e];
                if (threadIdx.x < 256) tokT[i * 256 + threadIdx.x] = (s0 + (int)threadIdx.x < ce) ? tok_of[e * ECAP + s0 + threadIdx.x] : 0; } }
            __syncthreads();
            g8::PolMoe1 pol{(const unsigned char*)(p.ws + WS_H1), (const unsigned char*)(p.ws + WS_WTGU), (unsigned char*)(p.ws + WS_HMID), tokT, pl, 2048, G, c};
            g8::gemm_phase(lds, pol); if constexpr ((DBL_MASK >> 8) & 1) g8::gemm_phase(lds, pol);
        }
        SEAM(8);
        if (IN(9)) { g8::PolMoe2 pol{(const unsigned char*)(p.ws + WS_HMID), (const unsigned char*)(p.ws + WS_WTDN), (unsigned char*)(p.ws + WS_YR), pl, 768, G, c};
            g8::gemm_phase(lds, pol); if constexpr ((DBL_MASK >> 9) & 1) g8::gemm_phase(lds, pol); }
        SEAM(9);
        if (IN(10)) phase_combine(p, pl);
    }
#undef IN
#undef SEAM
}

extern "C" void kernel_launch(void* const* d_in, const int* in_sizes, int n_in, void* d_out, int out_size, void* d_ws, size_t ws_size, hipStream_t stream) {
    static int inited = 0;
    if (!inited) { (void)hipFuncSetAttribute((const void*)mega, hipFuncAttributeMaxDynamicSharedMemorySize, LDS_BYTES); inited = 1; }
    unsigned char* wsb = (unsigned char*)d_ws;
    (void)hipMemsetAsync(wsb + WS_CTL, 0, CTL_BYTES, stream);
    Args a{}; for (int i = 0; i < 21; ++i) a.p.in[i] = (const float*)d_in[i]; a.p.out = (float*)d_out; a.p.ws = wsb; a.p.cvt_all = 7; a.p.mix_mask = 3; a.p.dbl = 0; a.p.pad = 0;
    a.ph_lo = 0; a.ph_hi = 11; a.bar_region = 0; a.pad = 0;
    hipLaunchKernelGGL(mega, dim3(256), dim3(NTHR), LDS_BYTES, stream, a);
}
```

```cpp
#include <hip/hip_runtime.h>
#include <hip/hip_bf16.h>
#include <stdint.h>
#ifndef DBL_MASK
#define DBL_MASK 0
#endif

constexpr int D_MODEL = 2048, BATCH = 8, SEQ = 2048, T_TOK = BATCH * SEQ;
constexpr int M_HEADS = 4, M_HD = 256, M_WIDTH = 1024, M_CHUNK = 64;
constexpr int A_HEADS = 16, A_KVH = 4, A_HD = 64, A_WIDTH = 1024, A_KVW = 256, WINDOW = 128;
constexpr int D_IN = 9736;
constexpr int N_GROUPS = 8, EPG = 8, N_EXP = 64, D_EXP = 768;
constexpr float EPS = 1e-6f;
constexpr int NZ = 9728, ZQ = 0, ZK = 1024, ZV = 2048, ZO = 3072, ZAQ = 4096, ZAK = 5120, ZAV = 5376, ZGM = 5632, ZGA = 7680;
constexpr int GATE_TILE0 = ZGM / 256;
constexpr int W_MI = 4096;
constexpr int ECAP = 16384;

typedef unsigned short bf16_t;
typedef short bf16x8 __attribute__((ext_vector_type(8)));
typedef float f32x4 __attribute__((ext_vector_type(4)));
typedef unsigned u32x4 __attribute__((ext_vector_type(4)));
typedef unsigned u32x2 __attribute__((ext_vector_type(2)));
#define LAS __attribute__((address_space(3)))

__device__ __forceinline__ float frcp(float x) { return __builtin_amdgcn_rcpf(x); }
__device__ __forceinline__ float sigmoidf_(float x) { return frcp(1.0f + __expf(-x)); }
__device__ __forceinline__ float siluf_(float x) { return x * frcp(1.0f + __expf(-x)); }
__device__ __forceinline__ float wave_sum(float v) { for (int o = 32; o >= 1; o >>= 1) v += __shfl_xor(v, o); return v; }
__device__ __forceinline__ float wave_max(float v) { for (int o = 32; o >= 1; o >>= 1) v = fmaxf(v, __shfl_xor(v, o)); return v; }
__device__ __forceinline__ float bf2f(bf16_t b) { return __uint_as_float(((unsigned)b) << 16); }
typedef float f32x2_t __attribute__((ext_vector_type(2)));
typedef __bf16 bf16x2_t __attribute__((ext_vector_type(2)));
__device__ __forceinline__ unsigned cvt_pk_bf16(float lo, float hi) { unsigned r; asm volatile("v_cvt_pk_bf16_f32 %0, %1, %2" : "=v"(r) : "v"(lo), "v"(hi)); return r; }
__device__ __forceinline__ unsigned pk_bf16_sw(float lo, float hi) { const f32x2_t v = {lo, hi}; const bf16x2_t r = __builtin_convertvector(v, bf16x2_t); unsigned u; __builtin_memcpy(&u, &r, 4); return u; }
__device__ __forceinline__ bf16_t f2bf(float f) { return (bf16_t)(cvt_pk_bf16(f, 0.f) & 0xffffu); }

#define XB_TMO      128
#define XB_XCNT(j)  (256  + 64 * (j))
#define XB_XSUB(j)  (1280 + 64 * (j))
#define XB_XGEN(j)  (2304 + 64 * (j))
#define XB_TOP      3328
#define XB_TOPGEN   3392
#define XCD_BAR_WORDS 3456
#define XB_SPIN_CAP (1u << 18)
__device__ __forceinline__ unsigned xb_ld(unsigned* p)              { return __hip_atomic_load(p, __ATOMIC_RELAXED, __HIP_MEMORY_SCOPE_AGENT); }
__device__ __forceinline__ unsigned xb_add(unsigned* p, unsigned v) { return __hip_atomic_fetch_add(p, v, __ATOMIC_RELAXED, __HIP_MEMORY_SCOPE_AGENT); }
__device__ __forceinline__ unsigned xb_xcc_id() { return (unsigned)__builtin_amdgcn_s_getreg((3 << 11) | 20) & 0xFu; }
#define XB_SPIN(cond, bar) do { unsigned _sp = 0; while (cond) { __builtin_amdgcn_s_sleep(1); \
    if ((++_sp & 255u) == 0u) { if (xb_ld(&(bar)[XB_TMO])) break; if (_sp > XB_SPIN_CAP) { atomicAdd(&(bar)[XB_TMO], 1u); break; } } } } while (0)
struct XcdBarrier { unsigned* bar; unsigned x; volatile LAS unsigned* st; };
__device__ __forceinline__ XcdBarrier xcd_barrier_post(unsigned* bar, volatile LAS unsigned* st) {
    XcdBarrier b; b.bar = bar; b.x = xb_xcc_id(); b.st = st;
    if (threadIdx.x == 0) (void)xb_add(&bar[XB_XCNT(b.x)], 1u);
    return b;
}
__device__ __forceinline__ void xcd_barrier_complete(unsigned* bar, unsigned x, unsigned& nloc, unsigned& nx) {
    const unsigned G = gridDim.x * gridDim.y * gridDim.z;
    unsigned sum, cnt, mine, sp = 0u;
    for (;;) {
        sum = 0u; cnt = 0u; mine = 0u;
#pragma unroll
        for (unsigned j = 0; j < 16; ++j) { const unsigned c = xb_ld(&bar[XB_XCNT(j)]); sum += c; cnt += (c > 0u) ? 1u : 0u; mine = (j == x) ? c : mine; }
        if (sum == G) break;
        __builtin_amdgcn_s_sleep(1);
        if ((++sp & 255u) == 0u) { if (xb_ld(&bar[XB_TMO])) break; if (sp > XB_SPIN_CAP) { atomicAdd(&bar[XB_TMO], 1u); break; } }
    }
    nloc = mine > 0u ? mine : 1u; nx = cnt > 0u ? cnt : 1u;
}
__device__ __forceinline__ void xcd_barrier(const XcdBarrier& b) {
    asm volatile("s_waitcnt vmcnt(0)" ::: "memory");
    __syncthreads();
    if (threadIdx.x == 0) {
        unsigned* bar = b.bar;
        __builtin_amdgcn_s_waitcnt(0);
        unsigned nloc = b.st[0], nx = b.st[1];
        if (nloc == 0u) { xcd_barrier_complete(bar, b.x, nloc, nx); b.st[0] = nloc; b.st[1] = nx; }
        const unsigned old = xb_add(&bar[XB_XSUB(b.x)], 1u);
        const unsigned gen = old / nloc;
        if (old + 1u == (gen + 1u) * nloc) {
            __builtin_amdgcn_fence(__ATOMIC_RELEASE, "agent");
            asm volatile("s_waitcnt vmcnt(0)" ::: "memory");
            const unsigned og = xb_add(&bar[XB_TOP], 1u);
            const unsigned tg = og / nx;
            if (og + 1u == (tg + 1u) * nx) xb_add(&bar[XB_TOPGEN], 1u);
            else XB_SPIN(xb_ld(&bar[XB_TOPGEN]) == tg, bar);
            __builtin_amdgcn_fence(__ATOMIC_ACQUIRE, "agent");
            xb_add(&bar[XB_XGEN(b.x)], 1u);
            asm volatile("s_waitcnt vmcnt(0)" ::: "memory");
        } else {
            XB_SPIN(xb_ld(&bar[XB_XGEN(b.x)]) == gen, bar);
            __builtin_amdgcn_fence(__ATOMIC_ACQUIRE, "agent");
            asm volatile("s_waitcnt vmcnt(0)" ::: "memory");
        }
    }
    __syncthreads();
}

namespace g8 {
constexpr int BM = 256, BK = 64, HALF = 128, HTB = HALF * BK * 2, STAGE_BYTES = 8 * HTB, NXCD = 8, WGM = 8;
__host__ __device__ __forceinline__ int lds_byte(int r, int c) { const int st = (r >> 4) * 2 + (c >> 5), rr = r & 15, cc = c & 31, ob = rr * 64 + cc * 2; return st * 1024 + (ob ^ (((ob >> 9) & 1) << 5)); }
__host__ __device__ __forceinline__ void stage_rc(int b, int& R, int& C) { const int st = b / 1024, sb = b % 1024, swz = sb ^ (((sb >> 9) & 1) << 5); R = (st >> 1) * 16 + swz / 64; C = (st & 1) * 32 + (swz % 64) / 2; }
__host__ __device__ __forceinline__ int perm32(int rho) { const int n = rho >> 4, i = rho & 15; return 8 * (i >> 2) + 4 * n + (i & 3); }
struct Unit { int pm, pn, a0, a1, nv; };
__device__ __forceinline__ void static_tile(int L, int nM, int nN, int& pm, int& pn) {
    const int nwg = nM * nN; int wgid = L; { const int q = nwg / NXCD, r = nwg % NXCD, xcd = wgid % NXCD, off = wgid / NXCD; wgid = (xcd < r ? xcd * (q + 1) : r * (q + 1) + (xcd - r) * q) + off; }
    const int nig = WGM * nN, gid = wgid / nig, fm = gid * WGM, gsz = (nM - fm) < WGM ? (nM - fm) : WGM;
    pm = fm + ((wgid % nig) % gsz); pn = (wgid % nig) / gsz;
}

typedef int i32x8 __attribute__((ext_vector_type(8)));
typedef int i32x4 __attribute__((ext_vector_type(4)));
__device__ __forceinline__ i32x8 cat8(bf16x8 lo, bf16x8 hi) { u32x4 a, b; __builtin_memcpy(&a, &lo, 16); __builtin_memcpy(&b, &hi, 16); i32x8 r = {(int)a.x, (int)a.y, (int)a.z, (int)a.w, (int)b.x, (int)b.y, (int)b.z, (int)b.w}; return r; }
__device__ __forceinline__ i32x4 as_i4(bf16x8 v) { i32x4 r; __builtin_memcpy(&r, &v, 16); return r; }
__device__ __forceinline__ i32x4 as_i4f(f32x4 v) { i32x4 r; __builtin_memcpy(&r, &v, 16); return r; }
__device__ __forceinline__ f32x4 as_f4(i32x4 v) { f32x4 r; __builtin_memcpy(&r, &v, 16); return r; }
template <class P>
__device__ __forceinline__ void gemm_phase(LAS unsigned char* lds, const P& pol) {
    const int tid = threadIdx.x, wid = __builtin_amdgcn_readfirstlane(tid >> 6), lane = tid & 63, wr = wid >> 2, wc = wid & 3, fr = lane & 15, fq = lane >> 4;
    constexpr int ES = P::ES;
    const int K = pol.K, RB = K * ES, nt = RB / 128;
    unsigned voffA[2][2], voffB[2]; int sR[2], sC[2];
#pragma unroll
    for (int i = 0; i < 2; ++i) { int R, C; stage_rc(tid * 16 + i * 8192, R, C); sR[i] = R; sC[i] = C; const int Rb = P::PERM ? ((R & ~31) + perm32(R & 31)) : R;
        voffA[0][i] = voffA[1][i] = (unsigned)(R * RB + C * 2); voffB[i] = (unsigned)(Rb * RB + C * 2); }
    const size_t kstep = (size_t)(BK * 2);
    const size_t hstepB = (size_t)HALF * RB;
    const size_t hstepA = P::GATHER ? (size_t)0 : hstepB;
    const unsigned ldsw = (unsigned)wid * 1024u;
    const int aoff = lds_byte(wr * 64 + fr, fq * 8), boff = lds_byte(wc * 32 + fr, fq * 8);
#define G8_SA(b, h) (((b) * 2 + (h)) * HTB)
#define G8_SB(b, h) ((4 + (b) * 2 + (h)) * HTB)
#define G8_STAGE_B(bufoff, gbase) do { _Pragma("unroll") for (int _i = 0; _i < 2; ++_i) \
        __builtin_amdgcn_global_load_lds((const unsigned*)((const char*)(gbase) + voffB[_i]), (LAS unsigned*)(lds + (bufoff) + ldsw + _i * 8192), 16, 0, 0); } while (0)
#define G8_STAGE_A(bufoff, gbase, h) do { _Pragma("unroll") for (int _i = 0; _i < 2; ++_i) \
        __builtin_amdgcn_global_load_lds((const unsigned*)((const char*)(gbase) + (h) * hstepA + voffA[P::GATHER ? (h) : 0][_i]), (LAS unsigned*)(lds + (bufoff) + ldsw + _i * 8192), 16, 0, 0); } while (0)
#define G8_LDA(dst, b, h) do { if constexpr (ES == 2 || P::I8) { _Pragma("unroll") for (int m = 0; m < 4; ++m) _Pragma("unroll") for (int k = 0; k < 2; ++k) dst[m][k] = *(const LAS bf16x8*)(lds + G8_SA(b, h) + aoff + m * 2048 + k * 1024); } else { \
        _Pragma("unroll") for (int m = 0; m < 4; ++m) { dst##8[m].lo = *(const LAS i32x4*)(lds + G8_SA(b, h) + aoff + m * 2048); dst##8[m].hi = *(const LAS i32x4*)(lds + G8_SA(b, h) + aoff + m * 2048 + 1024); } } } while (0)
#define G8_LDB(dst, b, h) do { if constexpr (ES == 2 || P::I8) { _Pragma("unroll") for (int n = 0; n < 2; ++n) _Pragma("unroll") for (int k = 0; k < 2; ++k) dst[n][k] = *(const LAS bf16x8*)(lds + G8_SB(b, h) + boff + n * 2048 + k * 1024); } else { \
        _Pragma("unroll") for (int n = 0; n < 2; ++n) { dst##8[n].lo = *(const LAS i32x4*)(lds + G8_SB(b, h) + boff + n * 2048); dst##8[n].hi = *(const LAS i32x4*)(lds + G8_SB(b, h) + boff + n * 2048 + 1024); } } } while (0)
#define G8_MMA(ai, bj, At, Bt) do { __builtin_amdgcn_s_setprio(1); if constexpr (ES == 2) { _Pragma("unroll") for (int m = 0; m < 4; ++m) _Pragma("unroll") for (int n = 0; n < 2; ++n) _Pragma("unroll") for (int k = 0; k < 2; ++k) \
        acc[ai][bj][m][n] = __builtin_amdgcn_mfma_f32_16x16x32_bf16(Bt[n][k], At[m][k], acc[ai][bj][m][n], 0, 0, 0); } else if constexpr (P::I8) { \
        _Pragma("unroll") for (int m = 0; m < 4; ++m) _Pragma("unroll") for (int n = 0; n < 2; ++n) _Pragma("unroll") for (int k = 0; k < 2; ++k) \
        acc[ai][bj][m][n] = as_f4(__builtin_amdgcn_mfma_i32_16x16x64_i8(as_i4(Bt[n][k]), as_i4(At[m][k]), as_i4f(acc[ai][bj][m][n]), 0, 0, 0)); } else { \
        _Pragma("unroll") for (int m = 0; m < 4; ++m) _Pragma("unroll") for (int n = 0; n < 2; ++n) acc[ai][bj][m][n] = __builtin_amdgcn_mfma_scale_f32_16x16x128_f8f6f4(Bt##8[n], At##8[m], acc[ai][bj][m][n], 0, 0, 0, 0, 0, 0); } \
        __builtin_amdgcn_s_setprio(0); } while (0)
#define G8_WAIT_V(n) asm volatile("s_waitcnt vmcnt(" #n ")" ::: "memory")
#define G8_WAIT_L(n) asm volatile("s_waitcnt lgkmcnt(" #n ")" ::: "memory")
#define G8_BAR __builtin_amdgcn_s_barrier()
#define G8_SCHED __builtin_amdgcn_sched_barrier(0)
#define G8_GATHER_OFFS(ui_, u_) do { if constexpr (P::GATHER) { _Pragma("unroll") for (int _h = 0; _h < 2; ++_h) _Pragma("unroll") for (int _i = 0; _i < 2; ++_i) \
        voffA[_h][_i] = pol.rowidx((ui_), (u_), _h * HALF + sR[_i]) * (unsigned)RB + (unsigned)sC[_i] * 2u; } } while (0)
    Unit cur, nxt; int ui = 0;
    if (!pol.next(0, cur)) return;
    f32x4 acc[2][2][4][2];
#pragma unroll
    for (int a = 0; a < 2; ++a)
#pragma unroll
        for (int b = 0; b < 2; ++b)
#pragma unroll
            for (int m = 0; m < 4; ++m)
#pragma unroll
                for (int n = 0; n < 2; ++n) acc[a][b][m][n] = (f32x4){0.f, 0.f, 0.f, 0.f};
    bf16x8 At[4][2], B0[2][2], B1[2][2]; i32x8 At8[4], B08[2], B18[2];
    const char* cA = pol.a_base(cur); const char* cB = pol.b_base(cur);
    G8_GATHER_OFFS(0, cur);
    G8_STAGE_B(G8_SB(0, 0), cB); G8_STAGE_B(G8_SB(0, 1), cB + hstepB); G8_STAGE_A(G8_SA(0, 0), cA, 0); G8_STAGE_A(G8_SA(0, 1), cA, 1);
    if (wr == 1) G8_BAR;
    G8_WAIT_V(2); G8_BAR;
    G8_STAGE_B(G8_SB(1, 0), cB + kstep); G8_STAGE_A(G8_SA(1, 0), cA + kstep, 0); G8_STAGE_B(G8_SB(1, 1), cB + hstepB + kstep);
    G8_WAIT_V(6); G8_BAR;
    for (;;) {
        const bool has_next = pol.next(ui + 1, nxt);
        const bool skip_hi = P::TAILS && cur.nv <= 128;
        const char* nA = has_next ? pol.a_base(nxt) : cA; const char* nB = has_next ? pol.b_base(nxt) : cB;
        for (int t = 0; t < nt; t += 2) {
            const bool last = (t == nt - 2);
            const char* a1 = cA + (size_t)(t + 1) * kstep;
            const char* a2 = last ? nA : cA + (size_t)(t + 2) * kstep; const char* b2 = last ? nB : cB + (size_t)(t + 2) * kstep;
            const char* a3 = a2 + kstep; const char* b3 = b2 + kstep;
            G8_LDB(B0, 0, 0); G8_LDB(B1, 0, 1); G8_SCHED; G8_LDA(At, 0, 0); G8_STAGE_A(G8_SA(1, 1), a1, 1);
            if (last && has_next) G8_GATHER_OFFS(ui + 1, nxt);
            G8_WAIT_V(8); G8_WAIT_L(0); G8_BAR; G8_MMA(0, 0, At, B0); G8_MMA(0, 1, At, B1); G8_BAR; G8_SCHED;
            G8_LDA(At, 0, 1); G8_STAGE_B(G8_SB(0, 0), b2); G8_STAGE_B(G8_SB(0, 1), b2 + hstepB); G8_STAGE_A(G8_SA(0, 0), a2, 0);
            G8_WAIT_V(8); G8_WAIT_L(0); G8_BAR; if (!skip_hi) { G8_MMA(1, 0, At, B0); G8_MMA(1, 1, At, B1); } G8_BAR; G8_SCHED;
            G8_LDB(B0, 1, 0); G8_LDB(B1, 1, 1); G8_SCHED; G8_LDA(At, 1, 0); G8_STAGE_A(G8_SA(0, 1), a2, 1);
            G8_WAIT_V(8); G8_WAIT_L(0); G8_BAR; G8_MMA(0, 0, At, B0); G8_MMA(0, 1, At, B1); G8_BAR; G8_SCHED;
            G8_LDA(At, 1, 1); G8_STAGE_B(G8_SB(1, 0), b3); G8_STAGE_B(G8_SB(1, 1), b3 + hstepB); G8_STAGE_A(G8_SA(1, 0), a3, 0);
            G8_WAIT_V(8); G8_WAIT_L(0); G8_BAR; if (!skip_hi) { G8_MMA(1, 0, At, B0); G8_MMA(1, 1, At, B1); } G8_BAR; G8_SCHED;
        }
        if (wr == 0) G8_BAR;
        const bool zero = pol.epi(acc, cur, wr, wc, fr, fq);
        if (!has_next) break;
        if (zero) {
#pragma unroll
        for (int a = 0; a < 2; ++a)
#pragma unroll
            for (int b = 0; b < 2; ++b)
#pragma unroll
                for (int m = 0; m < 4; ++m)
#pragma unroll
                    for (int n = 0; n < 2; ++n) acc[a][b][m][n] = (f32x4){0.f, 0.f, 0.f, 0.f};
        }
        cur = nxt; cA = nA; cB = nB; ++ui;
        if (wr == 1) G8_BAR;
    }
    G8_WAIT_V(0);
    G8_BAR;
#undef G8_SA
#undef G8_SB
#undef G8_STAGE_A
#undef G8_STAGE_B
#undef G8_LDA
#undef G8_LDB
#undef G8_MMA
#undef G8_WAIT_V
#undef G8_WAIT_L
#undef G8_BAR
#undef G8_SCHED
#undef G8_GATHER_OFFS
}

struct PolDenseBf16 {
    static constexpr bool PERM = true, GATHER = false, TAILS = false; static constexpr int ES = 2; static constexpr bool I8 = false;
    const bf16_t* A; const bf16_t* Bt; bf16_t* O; int M, N, K, ldc, G, c, ilo, ihi;
    __device__ __forceinline__ bool next(int i, Unit& u) const { const int nM = M / BM, nN = N / BM; const long L = (long)(i + ilo) * G + c; if (i + ilo >= ihi || L >= (long)nM * nN) return false; static_tile((int)L, nM, nN, u.pm, u.pn); u.a0 = 0; u.a1 = 0; u.nv = 256; return true; }
    __device__ __forceinline__ const char* a_base(const Unit& u) const { return (const char*)A + (size_t)u.pm * BM * K * 2; }
    __device__ __forceinline__ const char* b_base(const Unit& u) const { return (const char*)Bt + (size_t)u.pn * BM * K * 2; }
    __device__ __forceinline__ unsigned rowidx(int, const Unit&, int) const { return 0u; }
    __device__ __forceinline__ bool epi(f32x4 (&acc)[2][2][4][2], const Unit& u, int wr, int wc, int fr, int fq) const {
        const int row0 = u.pm * BM + wr * 64 + fr, col0 = u.pn * BM + wc * 32 + 8 * fq;
#pragma unroll
        for (int ai = 0; ai < 2; ++ai)
#pragma unroll
            for (int m = 0; m < 4; ++m) { bf16_t* rowp = O + (size_t)(row0 + ai * HALF + m * 16) * ldc + col0;
#pragma unroll
                for (int bj = 0; bj < 2; ++bj) { const f32x4 v0 = acc[ai][bj][m][0], v1 = acc[ai][bj][m][1];
                    u32x4 w; w.x = cvt_pk_bf16(v0[0], v0[1]); w.y = cvt_pk_bf16(v0[2], v0[3]); w.z = cvt_pk_bf16(v1[0], v1[1]); w.w = cvt_pk_bf16(v1[2], v1[3]);
                    *(u32x4*)(rowp + bj * HALF) = w; } }
        return true;
    }
};

struct PolDenseI8 {
    static constexpr bool PERM = true, GATHER = false, TAILS = false; static constexpr int ES = 1; static constexpr bool I8 = true;
    const signed char* A; const signed char* Bt; bf16_t* O; const float* sA; const float* sB; int M, N, K, ldc, G, c, ilo, ihi;
    __device__ __forceinline__ bool next(int i, Unit& u) const { const int nM = M / BM, nN = N / BM; const long L = (long)(i + ilo) * G + c; if (i + ilo >= ihi || L >= (long)nM * nN) return false; static_tile((int)L, nM, nN, u.pm, u.pn); u.a0 = 0; u.a1 = 0; u.nv = 256; return true; }
    __device__ __forceinline__ const char* a_base(const Unit& u) const { return (const char*)A + (size_t)u.pm * BM * K; }
    __device__ __forceinline__ const char* b_base(const Unit& u) const { return (const char*)Bt + (size_t)u.pn * BM * K; }
    __device__ __forceinline__ unsigned rowidx(int, const Unit&, int) const { return 0u; }
    __device__ __forceinline__ bool epi(f32x4 (&acc)[2][2][4][2], const Unit& u, int wr, int wc, int fr, int fq) const {
        const int row0 = u.pm * BM + wr * 64 + fr, col0 = u.pn * BM + wc * 32 + 8 * fq;
        f32x4 sb[2][2];
#pragma unroll
        for (int bj = 0; bj < 2; ++bj) { sb[bj][0] = *(const f32x4*)(sB + col0 + bj * HALF); sb[bj][1] = *(const f32x4*)(sB + col0 + bj * HALF + 4); }
#pragma unroll
        for (int ai = 0; ai < 2; ++ai)
#pragma unroll
            for (int m = 0; m < 4; ++m) { const int row = row0 + ai * HALF + m * 16; const float sa = sA[row]; bf16_t* rowp = O + (size_t)row * ldc + col0;
#pragma unroll
                for (int bj = 0; bj < 2; ++bj) { const i32x4 i0 = as_i4f(acc[ai][bj][m][0]), i1 = as_i4f(acc[ai][bj][m][1]);
                    const f32x4 v0 = (f32x4){(float)i0[0], (float)i0[1], (float)i0[2], (float)i0[3]} * sb[bj][0] * sa, v1 = (f32x4){(float)i1[0], (float)i1[1], (float)i1[2], (float)i1[3]} * sb[bj][1] * sa;
                    if (u.pn >= GATE_TILE0) {
                        unsigned q[8];
#pragma unroll
                        for (int e = 0; e < 8; ++e) { const float s = frcp(1.0f + __expf(-(e < 4 ? v0[e & 3] : v1[e & 3]))); const int qi = __float2int_rn(s * 255.0f); q[e] = (unsigned)(qi < 1 ? 1 : qi); }
                        u32x2 w; w.x = q[0] | (q[1] << 8) | (q[2] << 16) | (q[3] << 24); w.y = q[4] | (q[5] << 8) | (q[6] << 16) | (q[7] << 24);
                        *(u32x2*)((unsigned char*)O + (size_t)row * (ldc * 2) + ZGM * 2 + (col0 + bj * HALF - ZGM)) = w;
                    } else {
                    u32x4 w; w.x = cvt_pk_bf16(v0[0], v0[1]); w.y = cvt_pk_bf16(v0[2], v0[3]); w.z = cvt_pk_bf16(v1[0], v1[1]); w.w = cvt_pk_bf16(v1[2], v1[3]);
                    *(u32x4*)(rowp + bj * HALF) = w; } } }
        return true;
    }
};
struct PolProj {
    static constexpr bool PERM = true, GATHER = false, TAILS = false; static constexpr int ES = 2; static constexpr bool I8 = false;
    const bf16_t* hm; const bf16_t* ha; const bf16_t* Wm; const bf16_t* Wa; const bf16_t* z2; bf16_t* mixed; int K, G, c;
    __device__ __forceinline__ bool next(int i, Unit& u) const { const long L = (long)(i >> 1) * G + c; if (L >= 64 * 8) return false; static_tile((int)L, 64, 8, u.pm, u.pn); u.a0 = i & 1; u.a1 = 0; u.nv = 256; return true; }
    __device__ __forceinline__ const char* a_base(const Unit& u) const { return (const char*)(u.a0 ? ha : hm) + (size_t)u.pm * BM * K * 2; }
    __device__ __forceinline__ const char* b_base(const Unit& u) const { return (const char*)(u.a0 ? Wa : Wm) + (size_t)u.pn * BM * K * 2; }
    __device__ __forceinline__ unsigned rowidx(int, const Unit&, int) const { return 0u; }
    __device__ __forceinline__ bool epi(f32x4 (&acc)[2][2][4][2], const Unit& u, int wr, int wc, int fr, int fq) const {
        const int row0 = u.pm * BM + wr * 64 + fr, col0 = u.pn * BM + wc * 32 + 8 * fq;
#pragma unroll
        for (int ai = 0; ai < 2; ++ai)
#pragma unroll
            for (int m = 0; m < 4; ++m) { const size_t row = (size_t)(row0 + ai * HALF + m * 16);
#pragma unroll
                for (int bj = 0; bj < 2; ++bj) { const int col = col0 + bj * HALF;
                    const unsigned char* grow = (const unsigned char*)z2 + row * (NZ * 2) + ZGM * 2;
                    const u32x2 ga = *(const u32x2*)(grow + 2048 + col);
                    float sa[8];
#pragma unroll
                    for (int e = 0; e < 8; ++e) sa[e] = (float)(((e < 4 ? ga.x : ga.y) >> (8 * (e & 3))) & 0xffu);
                    if (u.a0 == 0) {
                        const u32x2 gm = *(const u32x2*)(grow + col);
#pragma unroll
                        for (int e = 0; e < 8; ++e) { const float sm = (float)(((e < 4 ? gm.x : gm.y) >> (8 * (e & 3))) & 0xffu); acc[ai][bj][m][e >> 2][e & 3] *= sm * frcp(sa[e]); }
                    } else {
                        float o[8];
#pragma unroll
                        for (int e = 0; e < 8; ++e) o[e] = acc[ai][bj][m][e >> 2][e & 3] * (sa[e] * (1.0f / 255.0f));
                        u32x4 w; w.x = cvt_pk_bf16(o[0], o[1]); w.y = cvt_pk_bf16(o[2], o[3]); w.z = cvt_pk_bf16(o[4], o[5]); w.w = cvt_pk_bf16(o[6], o[7]);
                        *(u32x4*)(mixed + row * 2048 + col) = w; } } }
        return u.a0 != 0;
    }
};
struct PolDenseBf16Res {
    static constexpr bool PERM = true, GATHER = false, TAILS = false; static constexpr int ES = 2; static constexpr bool I8 = false;
    const bf16_t* A; const bf16_t* Bt; const bf16_t* R; bf16_t* C; int M, N, K, ldc, G, c;
    __device__ __forceinline__ bool next(int i, Unit& u) const { const int nM = M / BM, nN = N / BM; const long L = (long)i * G + c; if (L >= (long)nM * nN) return false; static_tile((int)L, nM, nN, u.pm, u.pn); u.a0 = 0; u.a1 = 0; u.nv = 256; return true; }
    __device__ __forceinline__ const char* a_base(const Unit& u) const { return (const char*)A + (size_t)u.pm * BM * K * 2; }
    __device__ __forceinline__ const char* b_base(const Unit& u) const { return (const char*)Bt + (size_t)u.pn * BM * K * 2; }
    __device__ __forceinline__ unsigned rowidx(int, const Unit&, int) const { return 0u; }
    __device__ __forceinline__ bool epi(f32x4 (&acc)[2][2][4][2], const Unit& u, int wr, int wc, int fr, int fq) const {
        const int row0 = u.pm * BM + wr * 64 + fr, col0 = u.pn * BM + wc * 32 + 8 * fq;
#pragma unroll
        for (int ai = 0; ai < 2; ++ai)
#pragma unroll
            for (int m = 0; m < 4; ++m) { const size_t off = (size_t)(row0 + ai * HALF + m * 16) * ldc + col0;
#pragma unroll
                for (int bj = 0; bj < 2; ++bj) { const u32x4 rw = *(const u32x4*)(R + off + bj * HALF);
                    const f32x4 r0 = (f32x4){__uint_as_float(rw.x << 16), __uint_as_float(rw.x & 0xffff0000u), __uint_as_float(rw.y << 16), __uint_as_float(rw.y & 0xffff0000u)}, r1 = (f32x4){__uint_as_float(rw.z << 16), __uint_as_float(rw.z & 0xffff0000u), __uint_as_float(rw.w << 16), __uint_as_float(rw.w & 0xffff0000u)};
                    const f32x4 v0 = acc[ai][bj][m][0] + r0, v1 = acc[ai][bj][m][1] + r1;
                    u32x4 w; w.x = cvt_pk_bf16(v0[0], v0[1]); w.y = cvt_pk_bf16(v0[2], v0[3]); w.z = cvt_pk_bf16(v1[0], v1[1]); w.w = cvt_pk_bf16(v1[2], v1[3]);
                    *(u32x4*)(C + off + bj * HALF) = w; } }
        return true;
    }
};
struct MoePlan { const LAS int* cnt; const LAS int* tstart; const LAS int* rt2e; int NT; };
struct PolMoe1 {
    static constexpr bool PERM = true, GATHER = true, TAILS = true; static constexpr int ES = 1; static constexpr bool I8 = false;
    const unsigned char* hf; const unsigned char* Wgu; unsigned char* Hmid; const LAS int* tokT; MoePlan pl; int K, G, c;
    __device__ __forceinline__ bool next(int i, Unit& u) const { const int L = i * G + c; if (L >= pl.NT * 6) return false; const int rt = L / 6; u.pm = rt; u.pn = L - rt * 6; const int e = pl.rt2e[rt]; u.a0 = e; u.a1 = (rt - pl.tstart[e]) * 256; u.nv = pl.cnt[e] - u.a1; return true; }
    __device__ __forceinline__ const char* a_base(const Unit&) const { return (const char*)hf; }
    __device__ __forceinline__ const char* b_base(const Unit& u) const { return (const char*)Wgu + ((size_t)u.a0 * 1536 + (size_t)u.pn * 256) * 2048; }
    __device__ __forceinline__ unsigned rowidx(int ui, const Unit&, int r) const { return (unsigned)tokT[ui * 256 + r]; }
    __device__ __forceinline__ bool epi(f32x4 (&acc)[2][2][4][2], const Unit& u, int wr, int wc, int fr, int fq) const {
        const int row0 = u.pm * BM + wr * 64 + fr, col0 = u.pn * 128 + wc * 32 + 8 * fq;
#pragma unroll
        for (int ai = 0; ai < 2; ++ai)
#pragma unroll
            for (int m = 0; m < 4; ++m) { float o[8];
#pragma unroll
                for (int e = 0; e < 8; ++e) { const float gq = acc[ai][0][m][e >> 2][e & 3] * (1.0f / 64.0f), uq = acc[ai][1][m][e >> 2][e & 3] * (1.0f / 64.0f); o[e] = gq * frcp(1.0f + __expf(-gq)) * uq; }
                int w0 = 0, w1 = 0; w0 = __builtin_amdgcn_cvt_pk_fp8_f32(o[0], o[1], w0, false); w0 = __builtin_amdgcn_cvt_pk_fp8_f32(o[2], o[3], w0, true); w1 = __builtin_amdgcn_cvt_pk_fp8_f32(o[4], o[5], w1, false); w1 = __builtin_amdgcn_cvt_pk_fp8_f32(o[6], o[7], w1, true);
                u32x2 w; w.x = (unsigned)w0; w.y = (unsigned)w1; *(u32x2*)(Hmid + (size_t)(row0 + ai * HALF + m * 16) * 768 + col0) = w; }
        return true;
    }
};
struct PolMoe2 {
    static constexpr bool PERM = true, GATHER = false, TAILS = true; static constexpr int ES = 1; static constexpr bool I8 = false;
    const unsigned char* Hmid; const unsigned char* Wdn; unsigned char* yr; MoePlan pl; int K, G, c;
    __device__ __forceinline__ bool next(int i, Unit& u) const { const int L = i * G + c; if (L >= pl.NT * 8) return false; const int rt = L >> 3; u.pm = rt; u.pn = L & 7; const int e = pl.rt2e[rt]; u.a0 = e; u.a1 = 0; u.nv = pl.cnt[e] - (rt - pl.tstart[e]) * 256; return true; }
    __device__ __forceinline__ const char* a_base(const Unit& u) const { return (const char*)Hmid + (size_t)u.pm * BM * 768; }
    __device__ __forceinline__ const char* b_base(const Unit& u) const { return (const char*)Wdn + ((size_t)u.a0 * 2048 + (size_t)u.pn * 256) * 768; }
    __device__ __forceinline__ unsigned rowidx(int, const Unit&, int) const { return 0u; }
    __device__ __forceinline__ bool epi(f32x4 (&acc)[2][2][4][2], const Unit& u, int wr, int wc, int fr, int fq) const {
        const int row0 = u.pm * BM + wr * 64 + fr, col0 = u.pn * BM + wc * 32 + 8 * fq;
#pragma unroll
        for (int ai = 0; ai < 2; ++ai)
#pragma unroll
            for (int m = 0; m < 4; ++m) { unsigned char* rowp = yr + (size_t)(row0 + ai * HALF + m * 16) * 2048 + col0;
#pragma unroll
                for (int bj = 0; bj < 2; ++bj) { const f32x4 v0 = acc[ai][bj][m][0] * (1.0f / 32.0f), v1 = acc[ai][bj][m][1] * (1.0f / 32.0f);
                    int w0 = 0, w1 = 0; w0 = __builtin_amdgcn_cvt_pk_fp8_f32(v0[0], v0[1], w0, false); w0 = __builtin_amdgcn_cvt_pk_fp8_f32(v0[2], v0[3], w0, true); w1 = __builtin_amdgcn_cvt_pk_fp8_f32(v1[0], v1[1], w1, false); w1 = __builtin_amdgcn_cvt_pk_fp8_f32(v1[2], v1[3], w1, true);
                    u32x2 w; w.x = (unsigned)w0; w.y = (unsigned)w1; *(u32x2*)(rowp + bj * HALF) = w; } }
        return true;
    }
};
}

#define LDS_BARRIER() do { asm volatile("s_waitcnt lgkmcnt(0)" ::: "memory"); __builtin_amdgcn_s_barrier(); asm volatile("" ::: "memory"); } while (0)
constexpr int NTHR = 512, LDS_BYTES = 160 * 1024, LDS_MISC = 144 * 1024;

__device__ __forceinline__ void cvt_tile(const float* __restrict__ src, int ld, int k0, int ncol0, bf16_t* __restrict__ dst_row0, int K, int lane) {
    const int c8 = lane & 7, kg = lane >> 3;
    f32x4 v[2][8];
#pragma unroll
    for (int ps = 0; ps < 2; ++ps)
#pragma unroll
        for (int i = 0; i < 8; ++i) v[ps][i] = __builtin_nontemporal_load((const f32x4*)(src + (size_t)(k0 + kg * 8 + i) * ld + ncol0 + 32 * ps + 4 * c8));
#pragma unroll
    for (int ps = 0; ps < 2; ++ps)
#pragma unroll
        for (int j = 0; j < 4; ++j) { u32x4 w; w.x = cvt_pk_bf16(v[ps][0][j], v[ps][1][j]); w.y = cvt_pk_bf16(v[ps][2][j], v[ps][3][j]); w.z = cvt_pk_bf16(v[ps][4][j], v[ps][5][j]); w.w = cvt_pk_bf16(v[ps][6][j], v[ps][7][j]);
            *(u32x4*)(dst_row0 + (size_t)(32 * ps + 4 * c8 + j) * K + k0 + kg * 8) = w; }
}

struct Ptrs {
    const float* in[21]; float* out; unsigned char* ws; int cvt_all, mix_mask, dbl, pad;
};
constexpr size_t al256(size_t x) { return (x + 255) & ~(size_t)255; }
constexpr size_t WS_CTL = 0;
constexpr size_t CTL_BYTES = 65536;
constexpr size_t WS_LI = WS_CTL + CTL_BYTES;
constexpr size_t WS_LF = WS_LI + 32 * 2048 * 4;
constexpr size_t WS_BC = WS_LF + 32 * 2048 * 4;
constexpr size_t WS_UU = WS_BC + 32 * 2048 * 4;
constexpr size_t WS_PM = WS_UU + 32 * 2048 * 4;
constexpr size_t WS_WRH = WS_PM + 32 * 2048 * 4;
constexpr size_t WS_WRL = WS_WRH + 80 * 2048 * 2;
constexpr size_t WS_SA = WS_WRL + 80 * 2048 * 2;
constexpr size_t WS_SB = WS_SA + (size_t)T_TOK * 4;
constexpr size_t WS_WTIN = WS_SB + 10240 * 4;
constexpr size_t WS_WTPM = WS_WTIN + (size_t)NZ * 2048 * 2;
constexpr size_t WS_WTPA = WS_WTPM + (size_t)2048 * 1024 * 2;
constexpr size_t WS_WTOUT = WS_WTPA + (size_t)2048 * 1024 * 2;
constexpr size_t WS_WTGU = WS_WTOUT + (size_t)2048 * 2048 * 2;
constexpr size_t WS_WTDN = WS_WTGU + (size_t)64 * 1536 * 2048 * 2;
constexpr size_t WS_H1 = WS_WTDN + (size_t)64 * 2048 * 768 * 2;
constexpr size_t WS_X1B = WS_H1 + (size_t)T_TOK * 2048 * 2;
constexpr size_t WS_XB = WS_WTGU + (size_t)64 * 1536 * 2048;
constexpr size_t WS_HM = WS_H1 + (size_t)T_TOK * 2048 * 2;
constexpr size_t WS_HA = WS_HM + (size_t)T_TOK * 1024 * 2;
constexpr size_t WS_MIXED = WS_HA + (size_t)T_TOK * 1024 * 2;
constexpr size_t WS_TOKOF = WS_MIXED + (size_t)T_TOK * 2048 * 2;
constexpr size_t WS_ASG = WS_TOKOF + (size_t)N_EXP * ECAP * 4;
constexpr size_t WS_GW = WS_ASG + (size_t)T_TOK * 2 * 4;
constexpr size_t WS_QC = WS_GW + (size_t)T_TOK * 2 * 4;
constexpr size_t WS_KC = WS_QC + (size_t)T_TOK * 1024 * 2;
constexpr size_t WS_KT = WS_KC + (size_t)T_TOK * 1024 * 2;
constexpr size_t WS_VT = WS_KT + (size_t)T_TOK * 1024 * 2;
constexpr size_t WS_AQR = WS_VT + (size_t)T_TOK * 1024 * 2;
constexpr size_t WS_AKR = WS_AQR + (size_t)T_TOK * 1024 * 2;
constexpr size_t WS_AVT = WS_AKR + (size_t)T_TOK * 256 * 2;
constexpr size_t WS_HRAW = WS_AVT + (size_t)T_TOK * 256 * 2;
constexpr size_t WS_Z2 = WS_HRAW + (size_t)T_TOK * 1024 * 4;
constexpr size_t WS_HMID = WS_Z2;
constexpr size_t WS_YR = WS_HMID + (size_t)49152 * 768 * 2;
constexpr size_t WS_FAST_END = WS_Z2 + (size_t)T_TOK * NZ * 2;
static_assert(WS_YR + (size_t)49152 * 2048 * 2 <= WS_FAST_END, "Hmid + yr must fit in the z2 region");
constexpr int CW_BAR = 0;
constexpr int CW_CNT = 12288;
constexpr int MAXRT = 192;

struct CvtJob { const float* src; unsigned char* dst; int ld, K; float scale; };
__device__ __forceinline__ CvtJob cvt_expert_job(const Ptrs& p, int job) {
    CvtJob j;
    if (job < 64 * 24 * 32) {
        const int kl = job & 7, rest = job >> 3; const int nb = rest % 24, kb = ((rest / 24) & 3) * 8 + kl, e = rest / (24 * 4); const int pn = nb >> 2, q = nb & 3;
        j.src = p.in[(q < 2) ? 18 : 19] + (size_t)e * 2048 * 768 + (size_t)(kb * 64) * 768 + pn * 128 + (q & 1) * 64; j.ld = 768;
        j.dst = (unsigned char*)(p.ws + WS_WTGU) + ((size_t)e * 1536 + (size_t)nb * 64) * 2048 + kb * 64; j.K = 2048; j.scale = 64.0f;
    } else {
        const int jb = job - 64 * 24 * 32; const int kl = jb & 3, rest = jb >> 2; const int nb = rest % 32, kb = ((rest / 32) % 3) * 4 + kl, e = rest / (32 * 3);
        j.src = p.in[20] + (size_t)e * 768 * 2048 + (size_t)(kb * 64) * 2048 + nb * 64; j.ld = 2048;
        j.dst = (unsigned char*)(p.ws + WS_WTDN) + ((size_t)e * 2048 + (size_t)nb * 64) * 768 + kb * 64; j.K = 768; j.scale = 32.0f;
    }
    return j;
}
__device__ __forceinline__ void cvt_load(const CvtJob& j, int lane, f32x4 (&v)[2][8]) {
    const int c8 = lane & 7, kg = lane >> 3;
#pragma unroll
    for (int ps = 0; ps < 2; ++ps)
#pragma unroll
        for (int i = 0; i < 8; ++i) v[ps][i] = __builtin_nontemporal_load((const f32x4*)(j.src + (size_t)(kg * 8 + i) * j.ld + 32 * ps + 4 * c8));
}
__device__ __forceinline__ void cvt_store(const CvtJob& j, int lane, const f32x4 (&v)[2][8]) {
    const int c8 = lane & 7, kg = lane >> 3; const float s = j.scale;
#pragma unroll
    for (int ps = 0; ps < 2; ++ps)
#pragma unroll
        for (int jj = 0; jj < 4; ++jj) { int w0 = 0, w1 = 0;
            w0 = __builtin_amdgcn_cvt_pk_fp8_f32(v[ps][0][jj] * s, v[ps][1][jj] * s, w0, false); w0 = __builtin_amdgcn_cvt_pk_fp8_f32(v[ps][2][jj] * s, v[ps][3][jj] * s, w0, true);
            w1 = __builtin_amdgcn_cvt_pk_fp8_f32(v[ps][4][jj] * s, v[ps][5][jj] * s, w1, false); w1 = __builtin_amdgcn_cvt_pk_fp8_f32(v[ps][6][jj] * s, v[ps][7][jj] * s, w1, true);
            u32x2 w; w.x = (unsigned)w0; w.y = (unsigned)w1; *(u32x2*)(j.dst + (size_t)(32 * ps + 4 * c8 + jj) * j.K + kg * 8) = w; }
}
__device__ __forceinline__ void cvt_experts(const Ptrs& p, LAS unsigned char* lds) {
    const int tid = threadIdx.x, lane = tid & 63, wid = __builtin_amdgcn_readfirstlane(tid >> 6), c = blockIdx.x, c8 = lane & 7, kg = lane >> 3;
    constexpr int NJ = 64 * 24 * 32 + 64 * 32 * 12;
    const int nvw = gridDim.x * 8;
    LAS unsigned char* wl = lds + wid * 16384;
    __syncthreads();
#define CVT_ISSUE(J, ps, h) do { _Pragma("unroll") for (int _i = 0; _i < 8; ++_i) \
        __builtin_amdgcn_global_load_lds((const unsigned*)((J).src + (size_t)(kg * 8 + _i) * (J).ld + 32 * (ps) + 4 * c8), (LAS unsigned*)(wl + (h) * 8192 + _i * 1024), 16, 0, 0); } while (0)
#define CVT_FINISH(J, ps, h) do { f32x4 _v[8]; _Pragma("unroll") for (int _i = 0; _i < 8; ++_i) _v[_i] = *(const LAS f32x4*)(wl + (h) * 8192 + _i * 1024 + lane * 16); \
        const float _s = (J).scale; _Pragma("unroll") for (int _jj = 0; _jj < 4; ++_jj) { int _w0 = 0, _w1 = 0; \
            _w0 = __builtin_amdgcn_cvt_pk_fp8_f32(_v[0][_jj] * _s, _v[1][_jj] * _s, _w0, false); _w0 = __builtin_amdgcn_cvt_pk_fp8_f32(_v[2][_jj] * _s, _v[3][_jj] * _s, _w0, true); \
            _w1 = __builtin_amdgcn_cvt_pk_fp8_f32(_v[4][_jj] * _s, _v[5][_jj] * _s, _w1, false); _w1 = __builtin_amdgcn_cvt_pk_fp8_f32(_v[6][_jj] * _s, _v[7][_jj] * _s, _w1, true); \
            u32x2 _w; _w.x = (unsigned)_w0; _w.y = (unsigned)_w1; *(u32x2*)((J).dst + (size_t)(32 * (ps) + 4 * c8 + _jj) * (J).K + kg * 8) = _w; } \
        asm volatile("s_waitcnt lgkmcnt(0)" ::: "memory"); } while (0)
    constexpr int KA = 34; const bool bal = (gridDim.x == 256); int kq = 0;
#define CVT_JOBK(k) (!bal ? ((c * 8 + wid + (k) * nvw < NJ) ? c * 8 + wid + (k) * nvw : -1) : ((k) < KA ? c * 8 + wid + (k) * 2048 : ((c >= 128 && (k) < KA + 2 * (36 - KA)) ? KA * 2048 + ((c - 128) * 8 + wid) + ((k) - KA) * 1024 : -1)))
    int job = CVT_JOBK(0);
    if (job >= 0) {
        CvtJob ja = cvt_expert_job(p, job);
        CVT_ISSUE(ja, 0, 0); CVT_ISSUE(ja, 1, 1);
        for (;;) {
            ++kq; const int nj = CVT_JOBK(kq); const bool hn = nj >= 0; CvtJob jb = ja; if (hn) jb = cvt_expert_job(p, nj);
            asm volatile("s_waitcnt vmcnt(8)" ::: "memory");
            CVT_FINISH(ja, 0, 0);
            if (hn) { CVT_ISSUE(jb, 0, 0); asm volatile("s_waitcnt vmcnt(8)" ::: "memory"); } else asm volatile("s_waitcnt vmcnt(0)" ::: "memory");
            CVT_FINISH(ja, 1, 1);
            if (!hn) break;
            CVT_ISSUE(jb, 1, 1);
            ja = jb; job = nj;
        }
    }
    asm volatile("s_waitcnt vmcnt(0)" ::: "memory");
    for (int tj = c * 8 + wid; tj < 2048; tj += nvw) {
        if (tj < 1024) { const int which = tj >> 9, j2 = tj & 511, kl = j2 & 7, rest = j2 >> 3, nb = rest % 32, kb = (rest / 32) * 8 + kl;
            cvt_tile(p.in[10 + which], 2048, kb * 64, nb * 64, (bf16_t*)(p.ws + (which ? WS_WTPA : WS_WTPM)) + (size_t)nb * 64 * 1024, 1024, lane); }
        else { const int job = tj - 1024, kl = job & 7, rest = job >> 3; const int nb = rest % 32, kb = (rest / 32) * 8 + kl;
            cvt_tile(p.in[12], 2048, kb * 64, nb * 64, (bf16_t*)(p.ws + WS_WTOUT) + (size_t)nb * 64 * 2048, 2048, lane); } }
    { bf16_t* wrh = (bf16_t*)(p.ws + WS_WRH); bf16_t* wrl = (bf16_t*)(p.ws + WS_WRL); const float* gf = p.in[13]; const float* wgp = p.in[14]; const float* wep = p.in[16];
      for (int idx = blockIdx.x * NTHR + tid; idx < 80 * 256; idx += gridDim.x * NTHR) { const int j = idx >> 8, k8 = (idx & 255) * 8; float hi[8], lo[8];
#pragma unroll
          for (int i = 0; i < 8; ++i) { const int k = k8 + i; const float w = (j < 8) ? wgp[(size_t)k * 8 + j] : (j < 72 ? wep[(size_t)k * 64 + (j - 8)] : 0.f); const float v = w * gf[k];
              const float h = bf2f(f2bf(v)); hi[i] = h; lo[i] = v - h; }
          u32x4 a, bq; a.x = cvt_pk_bf16(hi[0], hi[1]); a.y = cvt_pk_bf16(hi[2], hi[3]); a.z = cvt_pk_bf16(hi[4], hi[5]); a.w = cvt_pk_bf16(hi[6], hi[7]);
          bq.x = cvt_pk_bf16(lo[0], lo[1]); bq.y = cvt_pk_bf16(lo[2], lo[3]); bq.z = cvt_pk_bf16(lo[4], lo[5]); bq.w = cvt_pk_bf16(lo[6], lo[7]);
          *(u32x4*)(wrh + (size_t)j * 2048 + k8) = a; *(u32x4*)(wrl + (size_t)j * 2048 + k8) = bq; } }
    __syncthreads();
#undef CVT_ISSUE
#undef CVT_FINISH
#undef CVT_JOBK
}

__device__ __forceinline__ void phase0(const Ptrs& p, LAS unsigned char* lds) {
    const int tid = threadIdx.x, lane = tid & 63, wid = tid >> 6, gw = blockIdx.x * 8 + wid, nw = gridDim.x * 8;
    { const float* w_in = p.in[2]; signed char* dst = (signed char*)(p.ws + WS_WTIN); float* sB = (float*)(p.ws + WS_SB); LAS float* cm = (LAS float*)lds;
      int tz = tid; asm volatile("" : "+v"(tz)); const int lane = tz & 63, wid = tz >> 6;
      const int c8 = lane & 7, kg = lane >> 3;
      for (int jn = blockIdx.x; jn < NZ / 64; jn += gridDim.x) { const int n0 = jn * 64; const float* srcp = w_in + n0 + (n0 >= 4096 ? 8 : 0) + (size_t)(wid * 256 + kg * 8) * D_IN + 4 * c8;
          float mx[2][4];
#pragma unroll
          for (int ps = 0; ps < 2; ++ps) {
#pragma unroll
              for (int jj = 0; jj < 4; ++jj) mx[ps][jj] = 0.f;
              for (int kb = 0; kb < 4; ++kb) { f32x4 v[8];
#pragma unroll
                  for (int i = 0; i < 8; ++i) v[i] = *(const f32x4*)(srcp + (size_t)(kb * 64 + i) * D_IN + 32 * ps);
#pragma unroll
                  for (int i = 0; i < 8; ++i)
#pragma unroll
                      for (int jj = 0; jj < 4; ++jj) mx[ps][jj] = fmaxf(mx[ps][jj], fabsf(v[i][jj]));
                  asm volatile("" ::: "memory"); }
#pragma unroll
              for (int jj = 0; jj < 4; ++jj) { float m = mx[ps][jj]; m = fmaxf(m, __shfl_xor(m, 8)); m = fmaxf(m, __shfl_xor(m, 16)); m = fmaxf(m, __shfl_xor(m, 32)); if (kg == 0) cm[wid * 64 + 32 * ps + 4 * c8 + jj] = m; } }
          __syncthreads();
#pragma unroll
          for (int ps = 0; ps < 2; ++ps) { float inv[4];
#pragma unroll
              for (int jj = 0; jj < 4; ++jj) { float m = 0.f;
#pragma unroll
                  for (int w8 = 0; w8 < 8; ++w8) m = fmaxf(m, cm[w8 * 64 + 32 * ps + 4 * c8 + jj]);
                  inv[jj] = m > 0.f ? 127.0f / m : 0.f; if (wid == 0 && kg == 0) sB[n0 + 32 * ps + 4 * c8 + jj] = m > 0.f ? m * (1.0f / 127.0f) : 1.0f; }
              for (int kb = 0; kb < 4; ++kb) { f32x4 v[8];
#pragma unroll
                  for (int i = 0; i < 8; ++i) v[i] = *(const f32x4*)(srcp + (size_t)(kb * 64 + i) * D_IN + 32 * ps);
#pragma unroll
                  for (int jj = 0; jj < 4; ++jj) { int q[8];
#pragma unroll
                      for (int i = 0; i < 8; ++i) q[i] = __float2int_rn(v[i][jj] * inv[jj]) & 0xff;
                      u32x2 w; w.x = (unsigned)(q[0] | (q[1] << 8) | (q[2] << 16) | (q[3] << 24)); w.y = (unsigned)(q[4] | (q[5] << 8) | (q[6] << 16) | (q[7] << 24));
                      *(u32x2*)(dst + (size_t)(n0 + 32 * ps + 4 * c8 + jj) * 2048 + wid * 256 + kb * 64 + kg * 8) = w; }
                  asm volatile("" ::: "memory"); } }
          __syncthreads(); } }
    LAS float* w8t = (LAS float*)lds;
    { const float* w_in = p.in[2];
      f32x4 wa[4], wb[4];
#pragma unroll
      for (int q = 0; q < 4; ++q) { const int k = tid + q * NTHR; wa[q] = *(const f32x4*)(w_in + (size_t)k * D_IN + W_MI); wb[q] = *(const f32x4*)(w_in + (size_t)k * D_IN + W_MI + 4); }
#pragma unroll
      for (int q = 0; q < 4; ++q) { const int k = tid + q * NTHR;
#pragma unroll
          for (int j = 0; j < 4; ++j) { w8t[j * 2048 + k] = wa[q][j]; w8t[(4 + j) * 2048 + k] = wb[q][j]; } } }
    __syncthreads();
    int tz2 = tid; asm volatile("" : "+v"(tz2)); const int lane2 = tz2 & 63;
    const float* x = p.in[0]; const float* g = p.in[1]; bf16_t* xbp = (bf16_t*)(p.ws + WS_XB); signed char* h8 = (signed char*)(p.ws + WS_H1); float* sA = (float*)(p.ws + WS_SA); float* li = (float*)(p.ws + WS_LI); float* lf = (float*)(p.ws + WS_LF);
    f32x4 gv[8];
#pragma unroll
    for (int i = 0; i < 8; ++i) gv[i] = *(const f32x4*)(g + i * 256 + lane2 * 4);
    const int rlo = (gridDim.x == 256) ? ((int)blockIdx.x < 152 ? 32 * (int)blockIdx.x : 4864 + 111 * ((int)blockIdx.x - 152)) : 0;
    const int rhi = (gridDim.x == 256) ? ((int)blockIdx.x < 152 ? rlo + 32 : (rlo + 111 < T_TOK ? rlo + 111 : T_TOK)) : T_TOK;
    const int rstep = (gridDim.x == 256) ? 8 : nw, rfirst = rlo + ((gridDim.x == 256) ? wid : gw);
    f32x4 vn[8];
    if (rfirst < rhi) {
#pragma unroll
        for (int i = 0; i < 8; ++i) vn[i] = *(const f32x4*)(x + (size_t)rfirst * 2048 + i * 256 + lane2 * 4); }
    for (int row = rfirst; row < rhi; row += rstep) {
        f32x4 v[8]; float ss = 0.f, amax = 0.f;
#pragma unroll
        for (int i = 0; i < 8; ++i) v[i] = vn[i];
        { const int nrow = row + rstep < rhi ? row + rstep : row;
#pragma unroll
          for (int i = 0; i < 8; ++i) vn[i] = *(const f32x4*)(x + (size_t)nrow * 2048 + i * 256 + lane2 * 4); }
#pragma unroll
        for (int i = 0; i < 8; ++i) { ss += v[i][0] * v[i][0] + v[i][1] * v[i][1] + v[i][2] * v[i][2] + v[i][3] * v[i][3];
            const f32x4 t = v[i] * gv[i]; amax = fmaxf(amax, fmaxf(fmaxf(fabsf(t[0]), fabsf(t[1])), fmaxf(fabsf(t[2]), fabsf(t[3])))); }
#pragma unroll
        for (int i = 0; i < 8; ++i) { u32x2 xw; xw.x = cvt_pk_bf16(v[i][0], v[i][1]); xw.y = cvt_pk_bf16(v[i][2], v[i][3]); *(u32x2*)(xbp + (size_t)row * 2048 + i * 256 + lane2 * 4) = xw; }
        ss = wave_sum(ss); const float r = rsqrtf(ss * (1.0f / 2048.f) + EPS);
        const float hmx = wave_max(amax) * r; const float hinv = hmx > 0.f ? 127.0f / hmx : 0.f; if (lane2 == 0) sA[row] = hmx > 0.f ? hmx * (1.0f / 127.0f) : 1.0f;
        float ga[8] = {0.f, 0.f, 0.f, 0.f, 0.f, 0.f, 0.f, 0.f};
#pragma unroll
        for (int i = 0; i < 8; ++i) { const f32x4 h = v[i] * r * gv[i];
            const int q0 = __float2int_rn(h[0] * hinv) & 0xff, q1 = __float2int_rn(h[1] * hinv) & 0xff, q2 = __float2int_rn(h[2] * hinv) & 0xff, q3 = __float2int_rn(h[3] * hinv);
            *(int*)(h8 + (size_t)row * 2048 + i * 256 + lane2 * 4) = q0 | (q1 << 8) | (q2 << 16) | (q3 << 24);
#pragma unroll
            for (int j = 0; j < 8; ++j) { const f32x4 wv = *(const LAS f32x4*)(w8t + j * 2048 + i * 256 + lane2 * 4); ga[j] += h[0] * wv[0] + h[1] * wv[1] + h[2] * wv[2] + h[3] * wv[3]; }
            asm volatile("" ::: "memory"); }
#pragma unroll
        for (int j = 0; j < 8; ++j) ga[j] = wave_sum(ga[j]);
        if (lane2 < 8) { float gsel = ga[0];
#pragma unroll
            for (int j = 1; j < 8; ++j) gsel = (lane2 == j) ? ga[j] : gsel;
            const int b = row / SEQ, s = row % SEQ, hh = lane2 & 3;
            if (lane2 < 4) li[(size_t)(b * 4 + hh) * SEQ + s] = gsel + p.in[4][hh];
            else { const float xf = gsel + p.in[5][hh]; lf[(size_t)(b * 4 + hh) * SEQ + s] = fminf(xf, 0.f) - log1pf(__expf(-fabsf(xf))); } }
    }
    __syncthreads();
}

constexpr int PL_CNT = 16, PL_TST = 80, PL_RT2E = 160, PL_NT = 160 + MAXRT, PL_TOKT = 384;
__device__ __forceinline__ g8::MoePlan build_plan(const unsigned* ctl, LAS unsigned char* lds) {
    LAS int* mi = (LAS int*)(lds + LDS_MISC);
    if (threadIdx.x < 64) mi[PL_CNT + threadIdx.x] = (int)__hip_atomic_load(ctl + CW_CNT + threadIdx.x, __ATOMIC_RELAXED, __HIP_MEMORY_SCOPE_AGENT);
    __syncthreads();
    if (threadIdx.x == 0) { int n = 0; for (int e = 0; e < 64; ++e) { mi[PL_TST + e] = n; const int nt = (mi[PL_CNT + e] + 255) >> 8; for (int q = 0; q < nt && n + q < MAXRT; ++q) mi[PL_RT2E + n + q] = e; n += nt; if (n > MAXRT) n = MAXRT; } mi[PL_TST + 64] = n; mi[PL_NT] = n; }
    __syncthreads();
    g8::MoePlan pl; pl.cnt = mi + PL_CNT; pl.tstart = mi + PL_TST; pl.rt2e = mi + PL_RT2E; pl.NT = mi[PL_NT];
    return pl;
}

__device__ __forceinline__ void phase_router(const Ptrs& p, LAS unsigned char* lds, unsigned* ctl, const bool commit) {
    const int tid = threadIdx.x, lane = tid & 63, wid = __builtin_amdgcn_readfirstlane(tid >> 6), g = lane >> 4, c = lane & 15;
    LAS float* LG = (LAS float*)lds;
    LAS float* SS = LG + 64 * 80;
    LAS float* rs = SS + 64;
    const bf16_t* x1 = (const bf16_t*)(p.ws + WS_X1B); const float* gfn = p.in[13];
    const bf16_t* wrh = (const bf16_t*)(p.ws + WS_WRH); const bf16_t* wrl = (const bf16_t*)(p.ws + WS_WRL);
    unsigned char* hf = (unsigned char*)(p.ws + WS_H1); int* tok_of = (int*)(p.ws + WS_TOKOF); int* asg = (int*)(p.ws + WS_ASG); float* gwt = (float*)(p.ws + WS_GW);
    for (int grp = blockIdx.x; grp < T_TOK / 64; grp += gridDim.x) {
        const int t0 = grp * 64;
        __syncthreads();
        f32x4 acc[4][5];
#pragma unroll
        for (int mt = 0; mt < 4; ++mt)
#pragma unroll
            for (int nt = 0; nt < 5; ++nt) acc[mt][nt] = (f32x4){0.f, 0.f, 0.f, 0.f};
        float ssq[4] = {0.f, 0.f, 0.f, 0.f};
        const bf16_t* xr = x1 + (size_t)(t0 + c) * 2048 + wid * 256 + 8 * g;
        const bf16_t* bhp = wrh + (size_t)c * 2048 + wid * 256 + 8 * g; const bf16_t* blp = wrl + (size_t)c * 2048 + wid * 256 + 8 * g;
#pragma unroll 2
        for (int ks = 0; ks < 8; ++ks) {
            bf16x8 ah[4];
#pragma unroll
            for (int mt = 0; mt < 4; ++mt) ah[mt] = *(const bf16x8*)(xr + (size_t)mt * 16 * 2048 + 32 * ks);
            bf16x8 bh[5], bl[5];
#pragma unroll
            for (int nt = 0; nt < 5; ++nt) { bh[nt] = *(const bf16x8*)(bhp + (size_t)nt * 16 * 2048 + 32 * ks); bl[nt] = *(const bf16x8*)(blp + (size_t)nt * 16 * 2048 + 32 * ks); }
#pragma unroll
            for (int mt = 0; mt < 4; ++mt) { u32x4 aw; __builtin_memcpy(&aw, &ah[mt], 16);
#pragma unroll
                for (int q = 0; q < 4; ++q) { const float a = __uint_as_float(aw[q] << 16), b2 = __uint_as_float(aw[q] & 0xffff0000u); ssq[mt] += a * a + b2 * b2; }
#pragma unroll
                for (int nt = 0; nt < 5; ++nt) { acc[mt][nt] = __builtin_amdgcn_mfma_f32_16x16x32_bf16(ah[mt], bh[nt], acc[mt][nt], 0, 0, 0); acc[mt][nt] = __builtin_amdgcn_mfma_f32_16x16x32_bf16(ah[mt], bl[nt], acc[mt][nt], 0, 0, 0); } }
        }
        LAS float* SL = rs + 64;
#pragma unroll
        for (int mt = 0; mt < 4; ++mt) { ssq[mt] += __shfl_xor(ssq[mt], 16); ssq[mt] += __shfl_xor(ssq[mt], 32); }
#pragma unroll
        for (int half = 4; half >= 1; half >>= 1) {
            if (wid >= half && wid < 2 * half) { LAS float* sl = SL + (wid - half) * 84 * 64;
#pragma unroll
                for (int mt = 0; mt < 4; ++mt) { sl[(80 + mt) * 64 + lane] = ssq[mt];
#pragma unroll
                    for (int nt = 0; nt < 5; ++nt)
#pragma unroll
                        for (int r = 0; r < 4; ++r) sl[((mt * 5 + nt) * 4 + r) * 64 + lane] = acc[mt][nt][r]; } }
            __syncthreads();
            if (wid < half) { const LAS float* sl = SL + wid * 84 * 64;
#pragma unroll
                for (int mt = 0; mt < 4; ++mt) { ssq[mt] += sl[(80 + mt) * 64 + lane];
#pragma unroll
                    for (int nt = 0; nt < 5; ++nt)
#pragma unroll
                        for (int r = 0; r < 4; ++r) acc[mt][nt][r] += sl[((mt * 5 + nt) * 4 + r) * 64 + lane]; } }
            __syncthreads();
        }
        if (wid == 0) {
#pragma unroll
            for (int mt = 0; mt < 4; ++mt) { if (g == 0) SS[16 * mt + c] = ssq[mt];
#pragma unroll
                for (int nt = 0; nt < 5; ++nt)
#pragma unroll
                    for (int r = 0; r < 4; ++r) LG[(16 * mt + 4 * g + r) * 80 + 16 * nt + c] = acc[mt][nt][r]; } }
        __syncthreads();
        if (tid < 64) rs[tid] = rsqrtf(SS[tid] * (1.0f / 2048.f) + EPS);
        __syncthreads();
        for (int q = 0; q < 8; q += 2) { const int tok = wid * 8 + q; const size_t row = (size_t)(t0 + tok); const float r0 = rs[tok], r1 = rs[tok + 1]; u32x2 v0[8], v1[8];
#pragma unroll
            for (int i = 0; i < 8; ++i) { v0[i] = *(const u32x2*)(x1 + row * 2048 + i * 256 + lane * 4); v1[i] = *(const u32x2*)(x1 + (row + 1) * 2048 + i * 256 + lane * 4); }
#pragma unroll
            for (int i = 0; i < 8; ++i) { const f32x4 gv = *(const f32x4*)(gfn + i * 256 + lane * 4);
                const f32x4 h0 = (f32x4){__uint_as_float(v0[i].x << 16), __uint_as_float(v0[i].x & 0xffff0000u), __uint_as_float(v0[i].y << 16), __uint_as_float(v0[i].y & 0xffff0000u)} * r0 * gv;
                const f32x4 h1 = (f32x4){__uint_as_float(v1[i].x << 16), __uint_as_float(v1[i].x & 0xffff0000u), __uint_as_float(v1[i].y << 16), __uint_as_float(v1[i].y & 0xffff0000u)} * r1 * gv;
                int w0 = 0, w1 = 0; w0 = __builtin_amdgcn_cvt_pk_fp8_f32(h0[0], h0[1], w0, false); w0 = __builtin_amdgcn_cvt_pk_fp8_f32(h0[2], h0[3], w0, true); w1 = __builtin_amdgcn_cvt_pk_fp8_f32(h1[0], h1[1], w1, false); w1 = __builtin_amdgcn_cvt_pk_fp8_f32(h1[2], h1[3], w1, true);
                *(int*)(hf + row * 2048 + i * 256 + lane * 4) = w0; *(int*)(hf + (row + 1) * 2048 + i * 256 + lane * 4) = w1; } }
        if (tid < 64 && commit) { const int t = t0 + tid; const LAS float* l = LG + tid * 80; const float r = rs[tid];
            float gm = -INFINITY; int gi = 0; float gl[8];
#pragma unroll
            for (int j = 0; j < 8; ++j) { gl[j] = l[j] * r + p.in[15][j]; if (gl[j] > gm) { gm = gl[j]; gi = j; } }
            float gs = 0.f;
#pragma unroll
            for (int j = 0; j < 8; ++j) gs += __expf(gl[j] - gm);
            const float gp = 1.0f / gs;
            float m0 = -INFINITY, m1 = -INFINITY; int i0 = 0, i1 = 0;
            for (int j = 0; j < 8; ++j) { const float e = l[8 + gi * 8 + j] * r + p.in[17][gi * 8 + j]; if (e > m0) { m1 = m0; i1 = i0; m0 = e; i0 = j; } else if (e > m1) { m1 = e; i1 = j; } }
            const float xx = __expf(m1 - m0); const float p0 = 1.0f / (1.0f + xx), p1 = xx / (1.0f + xx);
            const int e0 = gi * 8 + i0, e1 = gi * 8 + i1;
            const int s0 = (int)atomicAdd(ctl + CW_CNT + e0, 1u); tok_of[e0 * ECAP + s0] = t;
            const int s1 = (int)atomicAdd(ctl + CW_CNT + e1, 1u); tok_of[e1 * ECAP + s1] = t;
            asg[2 * t] = (e0 << 16) | s0; asg[2 * t + 1] = (e1 << 16) | s1; gwt[2 * t] = gp * p0; gwt[2 * t + 1] = gp * p1; }
    }
}

__device__ __forceinline__ void phase_combine(const Ptrs& p, const g8::MoePlan& pl) {
    const int lane = threadIdx.x & 63, gw = blockIdx.x * 8 + (threadIdx.x >> 6), nw = gridDim.x * 8;
    const int* asg = (const int*)(p.ws + WS_ASG); const float* gwt = (const float*)(p.ws + WS_GW); const unsigned char* yr = (const unsigned char*)(p.ws + WS_YR); const bf16_t* x1 = (const bf16_t*)(p.ws + WS_X1B); float* out = p.out;
    const int ntok = (T_TOK - gw + nw - 1) / nw;
    int my0 = 0, my1 = 0; float mw0 = 0.f, mw1 = 0.f;
    if (lane < ntok) { const int t = gw + lane * nw; const int a0 = asg[2 * t], a1 = asg[2 * t + 1]; mw0 = gwt[2 * t]; mw1 = gwt[2 * t + 1];
        my0 = pl.tstart[a0 >> 16] * 256 + (a0 & 0xffff); my1 = pl.tstart[a1 >> 16] * 256 + (a1 & 0xffff); }
    u32x4 ny0[2], ny1[2], nxw[2][2];
    if (ntok > 0) { const size_t r0 = (size_t)__shfl(my0, 0), r1 = (size_t)__shfl(my1, 0);
#pragma unroll
        for (int i = 0; i < 2; ++i) { const int col = i * 1024 + lane * 16; ny0[i] = *(const u32x4*)(yr + r0 * 2048 + col); ny1[i] = *(const u32x4*)(yr + r1 * 2048 + col);
            nxw[i][0] = *(const u32x4*)(x1 + (size_t)gw * 2048 + col); nxw[i][1] = *(const u32x4*)(x1 + (size_t)gw * 2048 + col + 8); } }
    for (int k = 0; k < ntok; ++k) { const int t = gw + k * nw;
        const float w0 = __shfl(mw0, k), w1 = __shfl(mw1, k);
        u32x4 y0[2], y1[2], xw[2][2];
#pragma unroll
        for (int i = 0; i < 2; ++i) { y0[i] = ny0[i]; y1[i] = ny1[i]; xw[i][0] = nxw[i][0]; xw[i][1] = nxw[i][1]; }
        { const int kn = (k + 1 < ntok) ? k + 1 : k; const int tn = gw + kn * nw; const size_t r0 = (size_t)__shfl(my0, kn), r1 = (size_t)__shfl(my1, kn);
#pragma unroll
          for (int i = 0; i < 2; ++i) { const int col = i * 1024 + lane * 16; ny0[i] = *(const u32x4*)(yr + r0 * 2048 + col); ny1[i] = *(const u32x4*)(yr + r1 * 2048 + col);
              nxw[i][0] = *(const u32x4*)(x1 + (size_t)tn * 2048 + col); nxw[i][1] = *(const u32x4*)(x1 + (size_t)tn * 2048 + col + 8); } }
#pragma unroll
        for (int i = 0; i < 2; ++i) { const int col = i * 1024 + lane * 16;
#pragma unroll
            for (int q = 0; q < 4; ++q) { const f32x2_t a0 = __builtin_amdgcn_cvt_pk_f32_fp8((int)y0[i][q], false), a1 = __builtin_amdgcn_cvt_pk_f32_fp8((int)y0[i][q], true), b0 = __builtin_amdgcn_cvt_pk_f32_fp8((int)y1[i][q], false), b1 = __builtin_amdgcn_cvt_pk_f32_fp8((int)y1[i][q], true);
                const unsigned xa = xw[i][q >> 1][(q & 1) * 2], xb = xw[i][q >> 1][(q & 1) * 2 + 1]; f32x4 x;
                x[0] = __uint_as_float(xa << 16) + w0 * a0.x + w1 * b0.x; x[1] = __uint_as_float(xa & 0xffff0000u) + w0 * a0.y + w1 * b0.y;
                x[2] = __uint_as_float(xb << 16) + w0 * a1.x + w1 * b1.x; x[3] = __uint_as_float(xb & 0xffff0000u) + w0 * a1.y + w1 * b1.y;
                *(f32x4*)(out + (size_t)t * 2048 + col + 4 * q) = x; } }
    }
}

__device__ __forceinline__ float scan_add64(float v, int lane) {
#pragma unroll
    for (int d = 1; d < 64; d <<= 1) { const float t = __shfl_up(v, d); if (lane >= d) v += t; }
    return v;
}
__device__ __forceinline__ float scan_max64(float v, int lane) {
#pragma unroll
    for (int d = 1; d < 64; d <<= 1) { const float t = __shfl_up(v, d); if (lane >= d) v = fmaxf(v, t); }
    return v;
}
__device__ __forceinline__ void tr8_store(const unsigned (&v)[8][4], bf16_t* dst0, size_t pitch) {
#pragma unroll
    for (int e = 0; e < 8; ++e) { const int q = e >> 1; u32x4 o;
        if (e & 1) { o.x = (v[0][q] >> 16) | (v[1][q] & 0xffff0000u); o.y = (v[2][q] >> 16) | (v[3][q] & 0xffff0000u); o.z = (v[4][q] >> 16) | (v[5][q] & 0xffff0000u); o.w = (v[6][q] >> 16) | (v[7][q] & 0xffff0000u); }
        else { o.x = (v[0][q] & 0xffffu) | (v[1][q] << 16); o.y = (v[2][q] & 0xffffu) | (v[3][q] << 16); o.z = (v[4][q] & 0xffffu) | (v[5][q] << 16); o.w = (v[6][q] & 0xffffu) | (v[7][q] << 16); }
        *(u32x4*)(dst0 + (size_t)e * pitch) = o; }
}
__device__ __forceinline__ void phase_prep(const Ptrs& p) {
    const int tid = threadIdx.x, lane = tid & 63, wid = tid >> 6;
    const bf16_t* z2 = (const bf16_t*)(p.ws + WS_Z2);
    bf16_t* qc = (bf16_t*)(p.ws + WS_QC); bf16_t* kc = (bf16_t*)(p.ws + WS_KC); bf16_t* kT = (bf16_t*)(p.ws + WS_KT); bf16_t* vT = (bf16_t*)(p.ws + WS_VT);
    bf16_t* aqr = (bf16_t*)(p.ws + WS_AQR); bf16_t* akr = (bf16_t*)(p.ws + WS_AKR); bf16_t* avT = (bf16_t*)(p.ws + WS_AVT);
    for (int item = blockIdx.x; item < T_TOK / 64; item += gridDim.x) {
        const int b = item >> 5, chunk = item & 31, s0 = chunk * 64; const size_t t0 = (size_t)item * 64;
        unsigned vv[2][8][4];
        { const int cg = tid & 127, tq = tid >> 7, ch0 = cg * 8;
#pragma unroll
          for (int oct = 0; oct < 2; ++oct)
#pragma unroll
              for (int tt = 0; tt < 8; ++tt) { const u32x4 x = *(const u32x4*)(z2 + (t0 + tq * 16 + oct * 8 + tt) * NZ + ZV + ch0); vv[oct][tt][0] = x[0]; vv[oct][tt][1] = x[1]; vv[oct][tt][2] = x[2]; vv[oct][tt][3] = x[3]; } }
        if (wid < 4) { const size_t gi = (size_t)(b * 4 + wid) * SEQ + s0 + lane; const float liv = ((const float*)(p.ws + WS_LI))[gi], lfv = ((const float*)(p.ws + WS_LF))[gi];
            const float bc = scan_add64(lfv, lane); const float u = liv - bc; const float pm = scan_max64(u, lane);
            ((float*)(p.ws + WS_BC))[gi] = bc; ((float*)(p.ws + WS_UU))[gi] = u; ((float*)(p.ws + WS_PM))[gi] = pm; }
        { int tz = tid; asm volatile("" : "+v"(tz)); const int cg = tz & 127, tq = tz >> 7, ch0 = cg * 8, hh = ch0 >> 8, dv0 = ch0 & 255;
#pragma unroll
          for (int oct = 0; oct < 2; ++oct) tr8_store(vv[oct], vT + (((size_t)(b * 4 + hh) * 32 + chunk) * 256 + dv0) * 64 + tq * 16 + oct * 8, 64); }
        { int tz = tid; asm volatile("" : "+v"(tz)); const int cg = tz & 255, th = tz >> 8, ch0 = cg * 8; const float* cw = p.in[3];
          float w[4][8];
#pragma unroll
          for (int j = 0; j < 4; ++j) { const f32x4 a = *(const f32x4*)(cw + j * 2048 + ch0), bq = *(const f32x4*)(cw + j * 2048 + ch0 + 4);
#pragma unroll
              for (int e = 0; e < 4; ++e) { w[j][e] = a[e]; w[j][4 + e] = bq[e]; } }
          float x0[8], x1[8], x2[8];
          const int sfirst = s0 + th * 32;
          { u32x4 hv[3];
#pragma unroll
            for (int d = 0; d < 3; ++d) hv[d] = (sfirst - 3 + d >= 0) ? *(const u32x4*)(z2 + (t0 + th * 32 - 3 + d) * NZ + ch0) : (u32x4){0u, 0u, 0u, 0u};
#pragma unroll
            for (int q = 0; q < 4; ++q) { x0[2 * q] = __uint_as_float(hv[0][q] << 16); x0[2 * q + 1] = __uint_as_float(hv[0][q] & 0xffff0000u); x1[2 * q] = __uint_as_float(hv[1][q] << 16); x1[2 * q + 1] = __uint_as_float(hv[1][q] & 0xffff0000u);
                x2[2 * q] = __uint_as_float(hv[2][q] << 16); x2[2 * q + 1] = __uint_as_float(hv[2][q] & 0xffff0000u); } }
          const bool isk = ch0 >= 1024; const int hh = (ch0 & 1023) >> 8, dk0 = ch0 & 255;
          for (int bt = 0; bt < 2; ++bt) { u32x4 raw[16];
#pragma unroll
              for (int tt = 0; tt < 16; ++tt) raw[tt] = *(const u32x4*)(z2 + (t0 + th * 32 + bt * 16 + tt) * NZ + ch0);
#pragma unroll
              for (int oc = 0; oc < 2; ++oc) { unsigned yo[8][4];
#pragma unroll
                  for (int tt = 0; tt < 8; ++tt) { const size_t t = t0 + th * 32 + bt * 16 + oc * 8 + tt; const u32x4 v = raw[oc * 8 + tt]; float f[8], y[8];
#pragma unroll
                      for (int q = 0; q < 4; ++q) { f[2 * q] = __uint_as_float(v[q] << 16); f[2 * q + 1] = __uint_as_float(v[q] & 0xffff0000u); }
#pragma unroll
                      for (int e = 0; e < 8; ++e) { float a = w[0][e] * x0[e] + w[1][e] * x1[e] + w[2][e] * x2[e] + w[3][e] * f[e]; a = a * frcp(1.0f + __expf(-a)); if (isk) a *= 0.0625f; y[e] = a; x0[e] = x1[e]; x1[e] = x2[e]; x2[e] = f[e]; }
                      u32x4 o; o.x = cvt_pk_bf16(y[0], y[1]); o.y = cvt_pk_bf16(y[2], y[3]); o.z = cvt_pk_bf16(y[4], y[5]); o.w = cvt_pk_bf16(y[6], y[7]);
                      *(u32x4*)((isk ? kc : qc) + t * 1024 + (ch0 & 1023)) = o; yo[tt][0] = o.x; yo[tt][1] = o.y; yo[tt][2] = o.z; yo[tt][3] = o.w; }
                  (void)yo; } }
        }
        unsigned av[8][4];
        if (tid < 256) { int tz = tid; asm volatile("" : "+v"(tz)); const int cg = tz & 31, tq = tz >> 5, ch0 = cg * 8;
#pragma unroll
            for (int tt = 0; tt < 8; ++tt) { const u32x4 x = *(const u32x4*)(z2 + (t0 + tq * 8 + tt) * NZ + ZAV + ch0); av[tt][0] = x[0]; av[tt][1] = x[1]; av[tt][2] = x[2]; av[tt][3] = x[3]; } }
        { int lz = lane; asm volatile("" : "+v"(lz)); const int l8 = lz & 7, i0 = (l8 & 3) * 8; const bool lowh = l8 < 4;
          float fr[8], gq8[8], gk8[8];
#pragma unroll
          for (int j = 0; j < 8; ++j) { fr[j] = exp2f(-(float)(i0 + j) * (13.287712379549449f / 32.0f)); gq8[j] = p.in[7][l8 * 8 + j]; gk8[j] = p.in[8][l8 * 8 + j]; }
          for (int tp = 0; tp < 4; ++tp) { const int tokA = wid * 8 + tp * 2;
              u32x4 raw[5];
#pragma unroll
              for (int m = 0; m < 5; ++m) { const int s = lz + 64 * m, sel = s >= 160 ? 1 : 0, sp = s - 160 * sel; raw[m] = *(const u32x4*)(z2 + (t0 + tokA + sel) * NZ + ZAQ + sp * 8); }
              float cs[2][8], sn[2][8];
#pragma unroll
              for (int u = 0; u < 2; ++u)
#pragma unroll
                  for (int j = 0; j < 8; ++j) { const float ang = (float)(s0 + tokA + u) * fr[j]; cs[u][j] = __cosf(ang); sn[u][j] = __sinf(ang); }
#pragma unroll
              for (int m = 0; m < 5; ++m) { const int s = lz + 64 * m, sel = s >= 160 ? 1 : 0, sp = s - 160 * sel, hx = sp >> 3; const size_t t = t0 + tokA + sel;
                  float v[8], ss = 0.f;
#pragma unroll
                  for (int q = 0; q < 4; ++q) { v[2 * q] = __uint_as_float(raw[m][q] << 16); v[2 * q + 1] = __uint_as_float(raw[m][q] & 0xffff0000u); ss += v[2 * q] * v[2 * q] + v[2 * q + 1] * v[2 * q + 1]; }
                  ss += __shfl_xor(ss, 1); ss += __shfl_xor(ss, 2); ss += __shfl_xor(ss, 4);
                  const float r = rsqrtf(ss * (1.0f / 64.f) + EPS); const bool isq = hx < 16; float o[8];
#pragma unroll
                  for (int j = 0; j < 8; ++j) { const float y = v[j] * r * (isq ? gq8[j] : gk8[j]); const float other = __shfl_xor(y, 4);
                      const float c_ = sel ? cs[1][j] : cs[0][j], s_ = sel ? sn[1][j] : sn[0][j];
                      const float oo = lowh ? (y * c_ - other * s_) : (y * c_ + other * s_); o[j] = isq ? oo * 0.125f : oo; }
                  u32x4 ow; ow.x = cvt_pk_bf16(o[0], o[1]); ow.y = cvt_pk_bf16(o[2], o[3]); ow.z = cvt_pk_bf16(o[4], o[5]); ow.w = cvt_pk_bf16(o[6], o[7]);
                  bf16_t* dp = isq ? (aqr + t * 1024 + hx * 64 + l8 * 8) : (akr + t * 256 + (hx - 16) * 64 + l8 * 8);
                  *(u32x4*)dp = ow; } } }
        if (tid < 256) { int tz = tid; asm volatile("" : "+v"(tz)); const int cg = tz & 31, tq = tz >> 5, ch0 = cg * 8, kvh = ch0 >> 6, dh0 = ch0 & 63;
            tr8_store(av, avT + ((size_t)(b * 4 + kvh) * 64 + dh0) * 2048 + s0 + tq * 8, 2048); }
    }
}

__device__ __forceinline__ void phase_attn(const Ptrs& p, LAS unsigned char* lds) {
    const int tid = threadIdx.x, lane = tid & 63, wid = tid >> 6, g = lane >> 4, c = lane & 15;
    const bf16_t* aqr = (const bf16_t*)(p.ws + WS_AQR); const bf16_t* akr = (const bf16_t*)(p.ws + WS_AKR); const bf16_t* avT = (const bf16_t*)(p.ws + WS_AVT); bf16_t* ha = (bf16_t*)(p.ws + WS_HA);
    constexpr int KP = 144, VP = 528;
    LAS unsigned char* Kl = lds; LAS unsigned char* Vl = lds + 256 * KP;
    const int cxa = ((gridDim.x & 7) == 0) ? (int)((blockIdx.x & 7) * (gridDim.x >> 3) + (blockIdx.x >> 3)) : (int)blockIdx.x;
    for (int unit = cxa; unit < 512; unit += gridDim.x) {
        const int b = unit >> 6, kvh = (unit >> 4) & 3, blk = unit & 15; const int sblk = blk * 128, kb0 = sblk - 128;
        __syncthreads();
#pragma unroll
        for (int q = 0; q < 4; ++q) { const int idx = tid + 512 * q, row = idx >> 3, ch = idx & 7; const int pos = kb0 + row; u32x4 v = (u32x4){0u, 0u, 0u, 0u};
            if (pos >= 0) v = *(const u32x4*)(akr + ((size_t)(b * 2048 + pos)) * 256 + kvh * 64 + ch * 8);
            *(LAS u32x4*)(Kl + row * KP + ch * 16) = v; }
#pragma unroll
        for (int q = 0; q < 4; ++q) { const int idx = tid + 512 * q, row = idx >> 5, ch = idx & 31; const int pos0 = kb0 + ch * 8; u32x4 v = (u32x4){0u, 0u, 0u, 0u};
            if (pos0 >= 0) v = *(const u32x4*)(avT + ((size_t)(b * 4 + kvh) * 64 + row) * 2048 + pos0);
            *(LAS u32x4*)(Vl + row * VP + ch * 16) = v; }
        __syncthreads();
        const int head = kvh * 4 + (wid >> 1), qh = wid & 1; const float sink = p.in[9][head];
        for (int qt = 0; qt < 4; ++qt) {
            const int q0 = qh * 64 + qt * 16; const size_t tokq = (size_t)b * 2048 + sblk + q0 + c;
            bf16x8 bq[2];
#pragma unroll
            for (int ks = 0; ks < 2; ++ks) bq[ks] = *(const bf16x8*)(aqr + tokq * 1024 + head * 64 + 8 * g + 32 * ks);
            const int kbase = (q0 >> 4) < 6 ? (q0 >> 4) : 6;
            f32x4 sacc[10];
#pragma unroll
            for (int i = 0; i < 10; ++i) { sacc[i] = (f32x4){0.f, 0.f, 0.f, 0.f};
#pragma unroll
                for (int ks = 0; ks < 2; ++ks) { const bf16x8 ka = *(const LAS bf16x8*)(Kl + (16 * (kbase + i) + c) * KP + (8 * g + 32 * ks) * 2);
                    sacc[i] = __builtin_amdgcn_mfma_f32_16x16x32_bf16(ka, bq[ks], sacc[i], 0, 0, 0); } }
            const int ql = q0 + c; float mloc = -INFINITY;
#pragma unroll
            for (int i = 0; i < 10; ++i)
#pragma unroll
                for (int r = 0; r < 4; ++r) { const int col = 16 * (kbase + i) + 4 * g + r; const bool ok = (col >= ql + 1) && (col <= ql + 128) && (kb0 + col >= 0);
                    const float s = ok ? sacc[i][r] : -INFINITY; sacc[i][r] = s; mloc = fmaxf(mloc, s); }
            mloc = fmaxf(mloc, __shfl_xor(mloc, 16)); mloc = fmaxf(mloc, __shfl_xor(mloc, 32)); const float mx = fmaxf(mloc, sink);
            float lsum = 0.f;
#pragma unroll
            for (int i = 0; i < 10; ++i)
#pragma unroll
                for (int r = 0; r < 4; ++r) { const float pv = __expf(sacc[i][r] - mx); sacc[i][r] = pv; lsum += pv; }
            lsum += __shfl_xor(lsum, 16); lsum += __shfl_xor(lsum, 32); const float inv = 1.0f / (lsum + __expf(sink - mx));
            f32x4 oacc[4];
#pragma unroll
            for (int mt = 0; mt < 4; ++mt) oacc[mt] = (f32x4){0.f, 0.f, 0.f, 0.f};
#pragma unroll
            for (int k2 = 0; k2 < 5; ++k2) { u32x4 pw; pw.x = cvt_pk_bf16(sacc[2 * k2][0] * inv, sacc[2 * k2][1] * inv); pw.y = cvt_pk_bf16(sacc[2 * k2][2] * inv, sacc[2 * k2][3] * inv);
                pw.z = cvt_pk_bf16(sacc[2 * k2 + 1][0] * inv, sacc[2 * k2 + 1][1] * inv); pw.w = cvt_pk_bf16(sacc[2 * k2 + 1][2] * inv, sacc[2 * k2 + 1][3] * inv);
                bf16x8 pb; __builtin_memcpy(&pb, &pw, 16);
#pragma unroll
                for (int mt = 0; mt < 4; ++mt) { const LAS unsigned char* vr = Vl + (16 * mt + c) * VP + (16 * (kbase + 2 * k2) + 4 * g) * 2;
                    const u32x2 lo = *(const LAS u32x2*)vr, hi = *(const LAS u32x2*)(vr + 32); u32x4 vw; vw.x = lo.x; vw.y = lo.y; vw.z = hi.x; vw.w = hi.y; bf16x8 va; __builtin_memcpy(&va, &vw, 16);
                    oacc[mt] = __builtin_amdgcn_mfma_f32_16x16x32_bf16(va, pb, oacc[mt], 0, 0, 0); } }
#pragma unroll
            for (int mt = 0; mt < 4; ++mt) { u32x2 o; o.x = pk_bf16_sw(oacc[mt][0], oacc[mt][1]); o.y = pk_bf16_sw(oacc[mt][2], oacc[mt][3]);
                *(u32x2*)(ha + tokq * 1024 + head * 64 + 16 * mt + 4 * g) = o; }
        }
    }
}

__device__ __forceinline__ bf16x8 scale_frag(bf16x8 f, const f32x4 wa, const f32x4 wb) {
    u32x4 w; __builtin_memcpy(&w, &f, 16); u32x4 o;
    o.x = cvt_pk_bf16(__uint_as_float(w.x << 16) * wa[0], __uint_as_float(w.x & 0xffff0000u) * wa[1]);
    o.y = cvt_pk_bf16(__uint_as_float(w.y << 16) * wa[2], __uint_as_float(w.y & 0xffff0000u) * wa[3]);
    o.z = cvt_pk_bf16(__uint_as_float(w.z << 16) * wb[0], __uint_as_float(w.z & 0xffff0000u) * wb[1]);
    o.w = cvt_pk_bf16(__uint_as_float(w.w << 16) * wb[2], __uint_as_float(w.w & 0xffff0000u) * wb[3]);
    bf16x8 r; __builtin_memcpy(&r, &o, 16); return r;
}
__device__ __forceinline__ void phase_mlstm(const Ptrs& p, LAS unsigned char* lds) {
    const int tid = threadIdx.x, lane = tid & 63, wid = __builtin_amdgcn_readfirstlane(tid >> 6), g = lane >> 4, c = lane & 15;
    constexpr int QP = 528, PP = 144, CP = 528;
    constexpr int OFF_Q = 0, OFF_K = 64 * QP, OFF_P = 2 * 64 * QP, OFF_CT = OFF_P + 64 * PP, CT_BYTES = 48 * CP, OFF_TAB = OFF_CT + 2 * CT_BYTES, TAB_BYTES = 2048, OFF_VS = OFF_TAB + 2 * TAB_BYTES, VSP = 144;
    const bf16_t* qc = (const bf16_t*)(p.ws + WS_QC); const bf16_t* kc = (const bf16_t*)(p.ws + WS_KC); const bf16_t* kT = (const bf16_t*)(p.ws + WS_KT); const bf16_t* vT = (const bf16_t*)(p.ws + WS_VT);
    const float* bcg = (const float*)(p.ws + WS_BC); const float* uug = (const float*)(p.ws + WS_UU); const float* pmg = (const float*)(p.ws + WS_PM); bf16_t* hraw = (bf16_t*)(p.ws + WS_HRAW);
    for (int unit = blockIdx.x; unit < 256; unit += gridDim.x) {
        const int js = (unit >> 3) & 7, bh = (unit & 7) + 8 * (unit >> 6), b = bh >> 2, h = bh & 3; const size_t tok0 = (size_t)b * SEQ;
        __syncthreads();
        for (int i = tid; i < CT_BYTES / 16; i += NTHR) *(LAS u32x4*)(lds + OFF_CT + i * 16) = (u32x4){0u, 0u, 0u, 0u};
        for (int i = tid; i < 48 * VSP / 16; i += NTHR) *(LAS u32x4*)(lds + OFF_VS + i * 16) = (u32x4){0u, 0u, 0u, 0u};
        f32x4 cacc[2][3];
#pragma unroll
        for (int x = 0; x < 2; ++x)
#pragma unroll
            for (int t3 = 0; t3 < 3; ++t3) cacc[x][t3] = (f32x4){0.f, 0.f, 0.f, 0.f};
        float mcar = 0.f;
        u32x4 pq[4], pk[4];
        bf16x8 kTf[2][2], vTh[2], vThn[2]; u32x2 vsr, vsn;
        float tbc = 0.f, tuu = 0.f, tpm = 0.f;
#define ML_LOAD_QK(ch) do { _Pragma("unroll") for (int q = 0; q < 4; ++q) { const int idx = tid + NTHR * q, row = idx >> 5, cc = idx & 31; const size_t off = (tok0 + (size_t)(ch) * 64 + row) * 1024 + h * 256 + cc * 8; \
            pq[q] = *(const u32x4*)(qc + off); pk[q] = *(const u32x4*)(kc + off); } } while (0)
#define ML_STORE_QK() do { _Pragma("unroll") for (int q = 0; q < 4; ++q) { const int idx = tid + NTHR * q, row = idx >> 5, cc = idx & 31; \
            *(LAS u32x4*)(lds + OFF_Q + row * QP + cc * 16) = pq[q]; *(LAS u32x4*)(lds + OFF_K + row * QP + cc * 16) = pk[q]; } } while (0)
#define ML_LOAD_T(ch, VH, VR) do { const size_t cb = ((size_t)bh * 32 + (ch)) * 256; \
            _Pragma("unroll") for (int k2 = 0; k2 < 2; ++k2) VH[k2] = *(const bf16x8*)(vT + (cb + 32 * js + 16 * (wid & 1) + c) * 64 + 8 * g + 32 * k2); \
            VR = *(const u32x2*)(vT + (cb + 32 * js + (tid >> 4)) * 64 + 4 * (tid & 15)); } while (0)
#define ML_TABLES(ch) do { if (wid == 0) { LAS float* tb = (LAS float*)(lds + OFF_TAB + ((ch) & 1) * TAB_BYTES); \
            const float bcum = tbc, u = tuu, pm = tpm; \
            const float mt = bcum + fmaxf(mcar, pm); const float bL = __shfl(bcum, 63), pmL = __shfl(pm, 63); const float mnew = fmaxf(bL + mcar, bL + pmL); \
            tb[lane] = bcum - mt; tb[64 + lane] = u; tb[128 + lane] = __expf(bcum + mcar - mt); tb[192 + lane] = __expf(-mt); tb[256 + lane] = __expf(bL + u - mnew); \
            if (lane == 0) tb[320] = __expf(bL + mcar - mnew); mcar = mnew; } } while (0)
#define ML_LOAD_G(ch) do { if (wid == 0) { const size_t gi = (size_t)bh * SEQ + (size_t)(ch) * 64 + lane; tbc = bcg[gi]; tuu = uug[gi]; tpm = pmg[gi]; } } while (0)
        ML_LOAD_G(0);
        ML_LOAD_QK(0); ML_LOAD_T(0, vTh, vsr); ML_STORE_QK(); ML_TABLES(0);
        ML_LOAD_G(1);
        ML_LOAD_QK(1);
        __syncthreads();
        for (int ch = 0; ch < 32; ++ch) {
            const LAS float* tb = (const LAS float*)(lds + OFF_TAB + (ch & 1) * TAB_BYTES);
            LAS unsigned char* CTcur = lds + OFF_CT + (ch & 1) * CT_BYTES; LAS unsigned char* CTnxt = lds + OFF_CT + ((ch + 1) & 1) * CT_BYTES;
            const int tm = wid >> 1, th = wid & 1;
            bf16x8 qa[8];
#pragma unroll
            for (int ks = 0; ks < 8; ++ks) qa[ks] = *(const LAS bf16x8*)(lds + OFF_Q + (16 * tm + c) * QP + (8 * g + 32 * ks) * 2);
            f32x4 sacc[2];
#pragma unroll
            for (int n = 0; n < 2; ++n) { sacc[n] = (f32x4){0.f, 0.f, 0.f, 0.f};
#pragma unroll
                for (int ks = 0; ks < 8; ++ks) { const bf16x8 kb = *(const LAS bf16x8*)(lds + OFF_K + (16 * (2 * th + n) + c) * QP + (8 * g + 32 * ks) * 2);
                    sacc[n] = __builtin_amdgcn_mfma_f32_16x16x32_bf16(qa[ks], kb, sacc[n], 0, 0, 0); } }
#pragma unroll
            for (int x = 0; x < 2; ++x)
#pragma unroll
                for (int k2 = 0; k2 < 2; ++k2) { typedef short s16x4 __attribute__((ext_vector_type(4)));
                    const LAS unsigned char* ka = lds + OFF_K + (32 * k2 + 8 * g + (c >> 2)) * QP + (16 * (2 * wid + x) + 4 * (c & 3)) * 2;
                    const s16x4 lo = __builtin_amdgcn_ds_read_tr16_b64_v4i16((LAS s16x4*)ka), hi = __builtin_amdgcn_ds_read_tr16_b64_v4i16((LAS s16x4*)(ka + 4 * QP));
                    kTf[x][k2] = (bf16x8){lo[0], lo[1], lo[2], lo[3], hi[0], hi[1], hi[2], hi[3]}; }
            { const f32x4 bm4 = *(const LAS f32x4*)(tb + 16 * tm + 4 * g);
#pragma unroll
              for (int n = 0; n < 2; ++n) { const int s = 16 * (2 * th + n) + c; const float us = tb[64 + s];
#pragma unroll
                  for (int r = 0; r < 4; ++r) { const int t = 16 * tm + 4 * g + r; const float pv = (s <= t) ? sacc[n][r] * __expf(bm4[r] + us) : 0.f;
                      *(LAS bf16_t*)(lds + OFF_P + t * PP + s * 2) = f2bf(pv); } } }
            { const f32x4 wk4 = *(const LAS f32x4*)(tb + 256 + 4 * (tid & 15));
              u32x2 o; o.x = cvt_pk_bf16(__uint_as_float(vsr.x << 16) * wk4[0], __uint_as_float(vsr.x & 0xffff0000u) * wk4[1]); o.y = cvt_pk_bf16(__uint_as_float(vsr.y << 16) * wk4[2], __uint_as_float(vsr.y & 0xffff0000u) * wk4[3]);
              *(LAS u32x2*)(lds + OFF_VS + (tid >> 4) * VSP + 8 * (tid & 15)) = o;
              if (tid < 16) { u32x2 e; e.x = cvt_pk_bf16(wk4[0], wk4[1]); e.y = cvt_pk_bf16(wk4[2], wk4[3]); *(LAS u32x2*)(lds + OFF_VS + 32 * VSP + 8 * tid) = e; } }
            LDS_BARRIER();
            if (ch + 1 < 32) ML_LOAD_T(ch + 1, vThn, vsn);
            { f32x4 hacc0 = (f32x4){0.f, 0.f, 0.f, 0.f}, hacc1 = (f32x4){0.f, 0.f, 0.f, 0.f};
#pragma unroll
              for (int ks = 0; ks < 8; ++ks) { const bf16x8 cb0 = *(const LAS bf16x8*)(CTcur + (16 * th + c) * CP + (8 * g + 32 * ks) * 2); const bf16x8 cb1 = *(const LAS bf16x8*)(CTcur + (32 + c) * CP + (8 * g + 32 * ks) * 2);
                  hacc0 = __builtin_amdgcn_mfma_f32_16x16x32_bf16(qa[ks], cb0, hacc0, 0, 0, 0); hacc1 = __builtin_amdgcn_mfma_f32_16x16x32_bf16(qa[ks], cb1, hacc1, 0, 0, 0); }
              const f32x4 wi4 = *(const LAS f32x4*)(tb + 128 + 16 * tm + 4 * g); hacc0 *= wi4; hacc1 *= wi4;
              const unsigned onew = (c == 0) ? 0x3f803f80u : 0u; const u32x4 ow = (u32x4){onew, onew, onew, onew}; bf16x8 ones; __builtin_memcpy(&ones, &ow, 16);
#pragma unroll
              for (int k2 = 0; k2 < 2; ++k2) { const bf16x8 pa = *(const LAS bf16x8*)(lds + OFF_P + (16 * tm + c) * PP + (8 * g + 32 * k2) * 2);
                  hacc0 = __builtin_amdgcn_mfma_f32_16x16x32_bf16(pa, vTh[k2], hacc0, 0, 0, 0); hacc1 = __builtin_amdgcn_mfma_f32_16x16x32_bf16(pa, ones, hacc1, 0, 0, 0); }
              const f32x4 ei4 = *(const LAS f32x4*)(tb + 192 + 16 * tm + 4 * g);
#pragma unroll
              for (int r = 0; r < 4; ++r) { const float qn = __shfl(hacc1[r], g * 16); const float den = fmaxf(fabsf(qn), ei4[r]);
                  hraw[(tok0 + (size_t)ch * 64 + 16 * tm + 4 * g + r) * 1024 + h * 256 + 32 * js + 16 * th + c] = f2bf(hacc0[r] * frcp(den)); } }
            { const float dec = tb[320]; bf16x8 vs[3][2];
#pragma unroll
              for (int t3 = 0; t3 < 3; ++t3)
#pragma unroll
                  for (int k2 = 0; k2 < 2; ++k2) vs[t3][k2] = *(const LAS bf16x8*)(lds + OFF_VS + (16 * t3 + c) * VSP + (8 * g + 32 * k2) * 2);
#pragma unroll
              for (int x = 0; x < 2; ++x)
#pragma unroll
                  for (int t3 = 0; t3 < 3; ++t3) { cacc[x][t3] *= dec;
#pragma unroll
                      for (int k2 = 0; k2 < 2; ++k2) cacc[x][t3] = __builtin_amdgcn_mfma_f32_16x16x32_bf16(kTf[x][k2], vs[t3][k2], cacc[x][t3], 0, 0, 0);
                      u32x2 o; o.x = pk_bf16_sw(cacc[x][t3][0], cacc[x][t3][1]); o.y = pk_bf16_sw(cacc[x][t3][2], cacc[x][t3][3]);
                      *(LAS u32x2*)(CTnxt + (16 * t3 + c) * CP + (16 * (2 * wid + x) + 4 * g) * 2) = o; } }
            if (ch + 1 < 32) { ML_STORE_QK(); ML_TABLES(ch + 1);
                vTh[0] = vThn[0]; vTh[1] = vThn[1]; vsr = vsn;
                if (ch + 2 < 32) { ML_LOAD_G(ch + 2); ML_LOAD_QK(ch + 2); } }
            LDS_BARRIER();
        }
#undef ML_LOAD_QK
#undef ML_STORE_QK
#undef ML_LOAD_T
#undef ML_TABLES
#undef ML_LOAD_G
    }
}

__device__ __forceinline__ void phase_hmpost(const Ptrs& p) {
    const int lane = threadIdx.x & 63, gw = blockIdx.x * 8 + (threadIdx.x >> 6), nw = gridDim.x * 8;
    const bf16_t* hraw = (const bf16_t*)(p.ws + WS_HRAW); const bf16_t* z2 = (const bf16_t*)(p.ws + WS_Z2); bf16_t* hm = (bf16_t*)(p.ws + WS_HM); const float* gm = p.in[6];
    f32x4 gv[4];
#pragma unroll
    for (int h = 0; h < 4; ++h) gv[h] = *(const f32x4*)(gm + h * 256 + lane * 4);
    for (int tt = gw; tt < T_TOK; tt += nw) { const size_t t = (size_t)tt; f32x4 v[4]; u32x2 mo[4]; float ss[4];
#pragma unroll
        for (int h = 0; h < 4; ++h) { { const u32x2 hv = *(const u32x2*)(hraw + t * 1024 + h * 256 + lane * 4); v[h] = (f32x4){__uint_as_float(hv.x << 16), __uint_as_float(hv.x & 0xffff0000u), __uint_as_float(hv.y << 16), __uint_as_float(hv.y & 0xffff0000u)}; } mo[h] = *(const u32x2*)(z2 + t * NZ + ZO + h * 256 + lane * 4); ss[h] = v[h][0] * v[h][0] + v[h][1] * v[h][1] + v[h][2] * v[h][2] + v[h][3] * v[h][3]; }
#pragma unroll
        for (int o = 32; o >= 1; o >>= 1) {
#pragma unroll
            for (int h = 0; h < 4; ++h) ss[h] += __shfl_xor(ss[h], o); }
#pragma unroll
        for (int h = 0; h < 4; ++h) { const float r = rsqrtf(ss[h] * (1.0f / 256.f) + EPS);
            const float o0 = v[h][0] * r * gv[h][0] * sigmoidf_(__uint_as_float(mo[h].x << 16)), o1 = v[h][1] * r * gv[h][1] * sigmoidf_(__uint_as_float(mo[h].x & 0xffff0000u));
            const float o2 = v[h][2] * r * gv[h][2] * sigmoidf_(__uint_as_float(mo[h].y << 16)), o3 = v[h][3] * r * gv[h][3] * sigmoidf_(__uint_as_float(mo[h].y & 0xffff0000u));
            u32x2 o; o.x = cvt_pk_bf16(o0, o1); o.y = cvt_pk_bf16(o2, o3); *(u32x2*)(hm + t * 1024 + h * 256 + lane * 4) = o; } }
}

struct Args { Ptrs p; int ph_lo, ph_hi, bar_region, pad; };
__global__ void __launch_bounds__(NTHR, 2) mega(Args args) {
    extern __shared__ __attribute__((aligned(16))) unsigned char lds_raw[];
    LAS unsigned char* lds = (LAS unsigned char*)lds_raw;
    const Ptrs& p = args.p;
    volatile LAS unsigned* xbw = (volatile LAS unsigned*)(lds + LDS_MISC);
    if (threadIdx.x < 4) xbw[threadIdx.x] = 0u;
    __syncthreads();
    unsigned* ctl = (unsigned*)(p.ws + WS_CTL);
    XcdBarrier bar = xcd_barrier_post(ctl + CW_BAR + args.bar_region * XCD_BAR_WORDS, xbw);
    const int lo = args.ph_lo, hi = args.ph_hi; const int G = (int)gridDim.x, c = (int)blockIdx.x;
#define IN(k) (lo <= (k) && (k) < hi)
#define SEAM(k) do { if (IN(k) && IN((k) + 1)) xcd_barrier(bar); } while (0)
    if (IN(0)) { phase0(p, lds); if constexpr ((DBL_MASK >> 0) & 1) phase0(p, lds); }
    SEAM(0);
    if (IN(1)) {
        const int grp = (c >> 3) & 1, nsplit = grp == 0 ? 0 : 1000;
        g8::PolDenseI8 pol{(const signed char*)(p.ws + WS_H1), (const signed char*)(p.ws + WS_WTIN), (bf16_t*)(p.ws + WS_Z2), (const float*)(p.ws + WS_SA), (const float*)(p.ws + WS_SB), T_TOK, NZ, 2048, NZ, G, c, 0, nsplit};
        g8::gemm_phase(lds, pol);
        cvt_experts(p, lds); if constexpr ((DBL_MASK >> 11) & 1) cvt_experts(p, lds);
        pol.ilo = nsplit; pol.ihi = 100000;
        g8::gemm_phase(lds, pol); if constexpr ((DBL_MASK >> 1) & 1) { pol.ilo = 0; g8::gemm_phase(lds, pol); } }
    SEAM(1);
    if (IN(2)) { phase_prep(p); if constexpr ((DBL_MASK >> 2) & 1) phase_prep(p); }
    SEAM(2);
    if (IN(3)) { if (p.mix_mask & 2) { phase_mlstm(p, lds); if constexpr ((DBL_MASK >> 3) & 1) phase_mlstm(p, lds); } if (p.mix_mask & 1) { phase_attn(p, lds); if constexpr ((DBL_MASK >> 4) & 1) phase_attn(p, lds); } }
    SEAM(3);
    if (IN(4)) { phase_hmpost(p); if constexpr ((DBL_MASK >> 7) & 1) phase_hmpost(p); }
    SEAM(4);
    if (IN(5)) { g8::PolProj pol{(const bf16_t*)(p.ws + WS_HM), (const bf16_t*)(p.ws + WS_HA), (const bf16_t*)(p.ws + WS_WTPM), (const bf16_t*)(p.ws + WS_WTPA), (const bf16_t*)(p.ws + WS_Z2), (bf16_t*)(p.ws + WS_MIXED), 1024, G, c};
        g8::gemm_phase(lds, pol); if constexpr ((DBL_MASK >> 5) & 1) g8::gemm_phase(lds, pol); }
    SEAM(5);
    if (IN(6)) { g8::PolDenseBf16Res pol{(const bf16_t*)(p.ws + WS_MIXED), (const bf16_t*)(p.ws + WS_WTOUT), (const bf16_t*)(p.ws + WS_XB), (bf16_t*)(p.ws + WS_X1B), T_TOK, 2048, 2048, 2048, G, c};
        g8::gemm_phase(lds, pol); if constexpr ((DBL_MASK >> 6) & 1) g8::gemm_phase(lds, pol); }
    SEAM(6);
    if (IN(7)) { if constexpr ((DBL_MASK >> 10) & 1) phase_router(p, lds, ctl, false); phase_router(p, lds, ctl, true); }
    SEAM(7);
    if (IN(8) || IN(9) || IN(10)) {
        const g8::MoePlan pl = build_plan(ctl, lds);
        const int cx = (c & 7) * (G >> 3) + (c >> 3);
        if (IN(8)) {
            LAS int* tokT = (LAS int*)(lds + LDS_MISC) + PL_TOKT; const int* tok_of = (const int*)(p.ws + WS_TOKOF);
            for (int i = 0; i < 5; ++i) { const int L = i * G + cx; if (L < pl.NT * 6) { const int rt = L / 6, e = pl.rt2e[rt], s0 = (rt - pl.tstart[e]) * 256, ce = pl.cnt[e];
                if (threadIdx.x < 256) tokT[i * 256 + threadIdx.x] = (s0 + (int)threadIdx.x < ce) ? tok_of[e * ECAP + s0 + threadIdx.x] : 0; } }
            __syncthreads();
            g8::PolMoe1 pol{(const unsigned char*)(p.ws + WS_H1), (const unsigned char*)(p.ws + WS_WTGU), (unsigned char*)(p.ws + WS_HMID), tokT, pl, 2048, G, cx};
            g8::gemm_phase(lds, pol); if constexpr ((DBL_MASK >> 8) & 1) g8::gemm_phase(lds, pol);
        }
        SEAM(8);
        if (IN(9)) { g8::PolMoe2 pol{(const unsigned char*)(p.ws + WS_HMID), (const unsigned char*)(p.ws + WS_WTDN), (unsigned char*)(p.ws + WS_YR), pl, 768, G, cx};
            g8::gemm_phase(lds, pol); if constexpr ((DBL_MASK >> 9) & 1) g8::gemm_phase(lds, pol); }
        SEAM(9);
        if (IN(10)) phase_combine(p, pl);
    }
#undef IN
#undef SEAM
}

extern "C" void kernel_launch(void* const* d_in, const int* in_sizes, int n_in, void* d_out, int out_size, void* d_ws, size_t ws_size, hipStream_t stream) {
    static int inited = 0;
    if (!inited) { (void)hipFuncSetAttribute((const void*)mega, hipFuncAttributeMaxDynamicSharedMemorySize, LDS_BYTES); inited = 1; }
    unsigned char* wsb = (unsigned char*)d_ws;
    (void)hipMemsetAsync(wsb + WS_CTL, 0, CTL_BYTES, stream);
    Args a{}; for (int i = 0; i < 21; ++i) a.p.in[i] = (const float*)d_in[i]; a.p.out = (float*)d_out; a.p.ws = wsb; a.p.cvt_all = 7; a.p.mix_mask = 3; a.p.dbl = 0; a.p.pad = 0;
    a.ph_lo = 0; a.ph_hi = 11; a.bar_region = 0; a.pad = 0;
    hipLaunchKernelGGL(mega, dim3(256), dim3(NTHR), LDS_BYTES, stream, a);
}
```
